# Optimizing an MI355X kernel written in HIP

```python
import math
import jax, jax.numpy as jnp
from jax import lax
import numpy as np


D_MODEL = 1024
BATCH = 16
SEQ = 2048
DEPTH = 1

GRID_W = 64
CTX_LEN = 256
MLA_HEADS = 8
MLA_NOPE = 64
MLA_ROPE = 32
MLA_V = 64
Q_LORA = 512
KV_LORA = 256
QBLK = 128
ROPE_BASE = 10000.0
DN_HEADS = 4
DN_DK = 128
DN_DV = 128
DN_QK = DN_HEADS * DN_DK
DN_VW = DN_HEADS * DN_DV
CONV_W = 3
CHUNK = 64
FF_HIDDEN = -(-8 * D_MODEL // (3 * 256)) * 256
EPS = 1e-6
IN_SIZES = (Q_LORA, KV_LORA, MLA_ROPE, 2 * DN_QK + DN_VW, DN_VW, 2 * DN_HEADS, 2 * DN_HEADS, D_MODEL, D_MODEL)
IN_COLS = sum(IN_SIZES)

kernel_name = 'hybrid_mla_gdn_flow_block'


def rmsnorm(x, g):
    xf = x.astype(jnp.float32)
    y = xf * lax.rsqrt(jnp.mean(xf * xf, axis=-1, keepdims=True) + EPS)
    return (y * g.astype(jnp.float32)).astype(x.dtype)


def l2norm(a):
    af = a.astype(jnp.float32)
    return (af * lax.rsqrt(jnp.sum(af * af, axis=-1, keepdims=True) + EPS)).astype(a.dtype)


def modulate(h, shift, scale):
    return h * (1.0 + scale) + shift


def split_cols(p):
    out = []
    start = 0
    for n in IN_SIZES:
        out.append(p[..., start:start + n])
        start += n
    return out


def axial_rope_tables(rows):
    row = jnp.repeat(jnp.arange(rows, dtype=jnp.float32), GRID_W)
    col = jnp.tile(jnp.arange(GRID_W, dtype=jnp.float32), rows)
    n_freq = MLA_ROPE // 4
    inv = ROPE_BASE ** (-jnp.arange(n_freq, dtype=jnp.float32) / n_freq)
    ang = jnp.concatenate([row[:, None] * inv, col[:, None] * inv], axis=-1)
    return jnp.cos(ang), jnp.sin(ang)


def apply_axial_rope(x, cos, sin):
    B, T, Hh, _ = x.shape
    n_freq = MLA_ROPE // 4
    xr = x.reshape(B, T, Hh, 2, 2, n_freq)
    cs = cos.reshape(T, 1, 2, n_freq).astype(x.dtype)
    sn = sin.reshape(T, 1, 2, n_freq).astype(x.dtype)
    x1, x2 = xr[..., 0, :], xr[..., 1, :]
    out = jnp.stack([x1 * cs - x2 * sn, x1 * sn + x2 * cs], axis=-2)
    return out.reshape(B, T, Hh, MLA_ROPE)


def mla_query(cq, g_q_lora, w_uq, cos, sin):
    B, T, _ = cq.shape
    q = (rmsnorm(cq, g_q_lora) @ w_uq).reshape(B, T, MLA_HEADS, MLA_NOPE + MLA_ROPE)
    if cos is None:
        return q
    return jnp.concatenate([q[..., :MLA_NOPE], apply_axial_rope(q[..., MLA_NOPE:], cos, sin)], axis=-1)


def mla_key_value(ckv, kr, g_kv_lora, w_ukv, cos, sin):
    B, T, _ = ckv.shape
    kv = (rmsnorm(ckv, g_kv_lora) @ w_ukv).reshape(B, T, MLA_HEADS, MLA_NOPE + MLA_V)
    k_rope = kr[:, :, None, :]
    if cos is not None:
        k_rope = apply_axial_rope(k_rope, cos, sin)
    k = jnp.concatenate([kv[..., :MLA_NOPE], jnp.broadcast_to(k_rope, (B, T, MLA_HEADS, MLA_ROPE))], axis=-1)
    return k, kv[..., MLA_NOPE:]


def attend(q, k, v):
    B, T, H, Dqk = q.shape
    nb = T // QBLK
    scale = Dqk ** -0.5
    qb = q.reshape(B, nb, QBLK, H, Dqk).swapaxes(0, 1)

    def block(qi):
        s = jnp.einsum('bqhd,bkhd->bhqk', qi, k).astype(jnp.float32) * scale
        p = jax.nn.softmax(s, axis=-1).astype(v.dtype)
        return jnp.einsum('bhqk,bkhd->bqhd', p, v)

    o = lax.map(block, qb)
    return o.swapaxes(0, 1).reshape(B, T, H, v.shape[-1])


def short_conv(u, w):
    T = u.shape[1]
    pad = CONV_W // 2
    up = jnp.pad(u, ((0, 0), (pad, pad), (0, 0)))
    out = up[:, 0:T] * w[0]
    for i in range(1, CONV_W):
        out = out + up[:, i:i + T] * w[i]
    return out


def deltanet_prep(qkv_raw, beta_raw, alpha_raw, conv_w, a_log, dt_bias):
    B, T, _ = qkv_raw.shape
    qkv = jax.nn.silu(short_conv(qkv_raw, conv_w))
    q = l2norm(qkv[..., :DN_QK].reshape(B, T, DN_HEADS, DN_DK))
    k = l2norm(qkv[..., DN_QK:2 * DN_QK].reshape(B, T, DN_HEADS, DN_DK))
    v = qkv[..., 2 * DN_QK:].reshape(B, T, DN_HEADS, DN_DV)
    beta = jax.nn.sigmoid(beta_raw.astype(jnp.float32)).reshape(B, T, 2, DN_HEADS)
    g = -jnp.exp(a_log.astype(jnp.float32)) * jax.nn.softplus(
        alpha_raw.astype(jnp.float32).reshape(B, T, 2, DN_HEADS) + dt_bias.astype(jnp.float32))
    return q, k, v, beta, g


def chunk_gated_delta(q, k, v, g, beta, s0, emit_out):
    out_dtype = v.dtype
    B, T, H, DK = k.shape
    DV = v.shape[-1]
    N = T // CHUNK
    f = jnp.float32

    def chunks(a):
        return a.astype(f).reshape(B, N, CHUNK, H, -1).transpose(1, 0, 3, 2, 4)

    kc, vc = chunks(k), chunks(v)
    gc = jnp.cumsum(chunks(g[..., None])[..., 0], axis=-1)
    bc = chunks(beta[..., None])[..., 0]
    idx = jnp.arange(CHUNK)
    incl = idx[:, None] >= idx[None, :]
    strict = idx[:, None] > idx[None, :]
    decay = jnp.exp(jnp.where(incl, gc[..., :, None] - gc[..., None, :], -jnp.inf))
    kk = jnp.einsum('nbhcd,nbhed->nbhce', kc, kc)
    a_mat = jnp.where(strict, kk * bc[..., :, None] * decay, 0.0) + jnp.eye(CHUNK, dtype=f)
    rhs = jnp.concatenate([vc * bc[..., None], kc * (bc * jnp.exp(gc))[..., None]], axis=-1)
    sol = lax.linalg.triangular_solve(a_mat, rhs, left_side=True, lower=True, unit_diagonal=True)
    u, w = sol[..., :DV], sol[..., DV:]
    if emit_out:
        qc = chunks(q) * DK ** -0.5
        qk = jnp.einsum('nbhcd,nbhed->nbhce', qc, kc) * decay
        xs = (kc, u, w, gc, qc, qk)
    else:
        xs = (kc, u, w, gc)

    def step(S, xs_i):
        k_i, u_i, w_i, g_i = xs_i[:4]
        v_new = u_i - jnp.einsum('bhcd,bhde->bhce', w_i, S)
        g_last = g_i[..., -1]
        S_next = S * jnp.exp(g_last)[..., None, None] + jnp.einsum(
            'bhcd,bhce->bhde', k_i * jnp.exp(g_last[..., None] - g_i)[..., None], v_new)
        if emit_out:
            q_i, qk_i = xs_i[4], xs_i[5]
            o = jnp.einsum('bhcd,bhde->bhce', q_i * jnp.exp(g_i)[..., None], S) + jnp.einsum(
                'bhce,bhef->bhcf', qk_i, v_new)
            return S_next, o
        return S_next, None

    s_final, o = lax.scan(step, s0.astype(f), xs)
    if not emit_out:
        return None, s_final
    o = o.transpose(1, 0, 3, 2, 4).reshape(B, T, H, DV).astype(out_dtype)
    return o, s_final


def flip(a):
    return jnp.flip(a, axis=1)


def gated_rmsnorm(o, z, g):
    B, T = o.shape[:2]
    y = rmsnorm(o, g) * jax.nn.silu(z.reshape(o.shape))
    return y.reshape(B, T, -1)


def merge_branches(o_mla, o_dn, gate_a, gate_b, w_o_mla, w_o_dn, w_out):
    B, T = o_mla.shape[:2]
    y_a = o_mla.reshape(B, T, -1) @ w_o_mla
    y_b = o_dn @ w_o_dn
    return (jax.nn.sigmoid(gate_a) * y_a + jax.nn.sigmoid(gate_b) * y_b) @ w_out


def token_mixer(u, uc, cos, sin, with_ctx_out, w_in, g_q_lora, w_uq, g_kv_lora, w_ukv, w_o_mla,
                conv_qkv, a_log, dt_bias, g_dn_out, w_o_dn, w_out):
    cq, ckv, kr, qkv_raw, z, beta_raw, alpha_raw, gate_a, gate_b = split_cols(u @ w_in)
    cq_c, ckv_c, kr_c, qkv_c, z_c, beta_c, alpha_c, gate_a_c, gate_b_c = split_cols(uc @ w_in)
    q = mla_query(cq, g_q_lora, w_uq, cos, sin)
    k, v = mla_key_value(ckv, kr, g_kv_lora, w_ukv, cos, sin)
    k_c, v_c = mla_key_value(ckv_c, kr_c, g_kv_lora, w_ukv, None, None)
    o_mla = attend(q, jnp.concatenate([k, k_c], axis=1), jnp.concatenate([v, v_c], axis=1))
    ql, kl, vl, bl, gl = deltanet_prep(qkv_raw, beta_raw, alpha_raw, conv_qkv, a_log, dt_bias)
    qx, kx, vx, bx, gx = deltanet_prep(qkv_c, beta_c, alpha_c, conv_qkv, a_log, dt_bias)
    s0 = jnp.zeros((u.shape[0], DN_HEADS, DN_DK, DN_DV), jnp.float32)
    of_c, sf_c = chunk_gated_delta(qx, kx, vx, gx[:, :, 0], bx[:, :, 0], s0, with_ctx_out)
    ob_c, sb_c = chunk_gated_delta(flip(qx), flip(kx), flip(vx), flip(gx[:, :, 1]), flip(bx[:, :, 1]), s0, with_ctx_out)
    of_l, _ = chunk_gated_delta(ql, kl, vl, gl[:, :, 0], bl[:, :, 0], sf_c, True)
    ob_l, _ = chunk_gated_delta(flip(ql), flip(kl), flip(vl), flip(gl[:, :, 1]), flip(bl[:, :, 1]), sb_c, True)
    o_dn = gated_rmsnorm(of_l + flip(ob_l), z, g_dn_out)
    y = merge_branches(o_mla, o_dn, gate_a, gate_b, w_o_mla, w_o_dn, w_out)
    if not with_ctx_out:
        return y, None
    q_c = mla_query(cq_c, g_q_lora, w_uq, None, None)
    o_mla_c = attend(q_c, k_c, v_c)
    o_dn_c = gated_rmsnorm(of_c + flip(ob_c), z_c, g_dn_out)
    y_c = merge_branches(o_mla_c, o_dn_c, gate_a_c, gate_b_c, w_o_mla, w_o_dn, w_out)
    return y, y_c


def swiglu(u, w_in, w_out):
    gu = u @ w_in
    return (jax.nn.silu(gu[..., :FF_HIDDEN]) * gu[..., FF_HIDDEN:]) @ w_out


def setup_inputs(seed: int = 0) -> dict:
    key = jax.random.key(seed)
    ks = jax.random.split(key, 26)
    L = DEPTH
    f = jnp.float32

    def nrm(k, shape, fan_in, s=1.0):
        return jax.random.normal(k, shape, f) * (s * fan_in ** -0.5)

    def gain(k, n):
        return 1.0 + 0.1 * jax.random.normal(k, (L, n), f)

    dt = jnp.exp(jax.random.uniform(ks[20], (L, 2, DN_HEADS), f, minval=math.log(1e-3), maxval=math.log(1e-1)))
    return {
        'x': jax.random.normal(ks[0], (BATCH, SEQ, D_MODEL), f),
        'c': jax.random.normal(ks[1], (BATCH, D_MODEL), f),
        'ctx': jax.random.normal(ks[2], (BATCH, CTX_LEN, D_MODEL), f),
        'c_ctx': jax.random.normal(ks[3], (D_MODEL,), f),
        'w_mod': nrm(ks[4], (L, D_MODEL, 6 * D_MODEL), D_MODEL, 0.5),
        'b_mod': 0.02 * jax.random.normal(ks[5], (L, 6 * D_MODEL), f),
        'g_pre_mix': gain(ks[6], D_MODEL),
        'g_post_mix': gain(ks[7], D_MODEL),
        'g_pre_ffn': gain(ks[8], D_MODEL),
        'g_post_ffn': gain(ks[9], D_MODEL),
        'w_in': nrm(ks[10], (L, D_MODEL, IN_COLS), D_MODEL),
        'g_q_lora': gain(ks[11], Q_LORA),
        'w_uq': nrm(ks[12], (L, Q_LORA, MLA_HEADS * (MLA_NOPE + MLA_ROPE)), Q_LORA),
        'g_kv_lora': gain(ks[13], KV_LORA),
        'w_ukv': nrm(ks[14], (L, KV_LORA, MLA_HEADS * (MLA_NOPE + MLA_V)), KV_LORA),
        'w_o_mla': nrm(ks[15], (L, MLA_HEADS * MLA_V, D_MODEL), MLA_HEADS * MLA_V),
        'conv_qkv': nrm(ks[16], (L, CONV_W, 2 * DN_QK + DN_VW), CONV_W),
        'a_log': jnp.log(jax.random.uniform(ks[17], (L, 2, DN_HEADS), f, minval=1.0, maxval=16.0)),
        'dt_bias': dt + jnp.log(-jnp.expm1(-dt)),
        'g_dn_out': gain(ks[18], DN_DV),
        'w_o_dn': nrm(ks[19], (L, DN_VW, D_MODEL), DN_VW),
        'w_out': nrm(ks[21], (L, D_MODEL, D_MODEL), D_MODEL),
        'w_ffn_in': nrm(ks[22], (L, D_MODEL, 2 * FF_HIDDEN), D_MODEL),
        'w_ffn_out': nrm(ks[23], (L, FF_HIDDEN, D_MODEL), FF_HIDDEN),
    }


def reference(x, c, ctx, c_ctx, w_mod, b_mod, g_pre_mix, g_post_mix, g_pre_ffn, g_post_ffn, w_in,
              g_q_lora, w_uq, g_kv_lora, w_ukv, w_o_mla, conv_qkv, a_log, dt_bias, g_dn_out, w_o_dn,
              w_out, w_ffn_in, w_ffn_out):
    rows = x.shape[1] // GRID_W
    cos, sin = axial_rope_tables(rows)
    h_c = ctx
    for layer in range(DEPTH):
        ctx_out = layer < DEPTH - 1
        mod = jax.nn.silu(c) @ w_mod[layer] + b_mod[layer]
        mod_c = jax.nn.silu(c_ctx) @ w_mod[layer] + b_mod[layer]
        sh1, sc1, gt1, sh2, sc2, gt2 = jnp.split(mod[:, None, :], 6, axis=-1)
        sh1c, sc1c, gt1c, sh2c, sc2c, gt2c = jnp.split(mod_c, 6)
        u = modulate(rmsnorm(x, g_pre_mix[layer]), sh1, sc1)
        uc = modulate(rmsnorm(h_c, g_pre_mix[layer]), sh1c, sc1c)
        y, y_c = token_mixer(u, uc, cos, sin, ctx_out, w_in[layer], g_q_lora[layer], w_uq[layer],
                             g_kv_lora[layer], w_ukv[layer], w_o_mla[layer], conv_qkv[layer], a_log[layer],
                             dt_bias[layer], g_dn_out[layer], w_o_dn[layer], w_out[layer])
        x = x + gt1 * rmsnorm(y, g_post_mix[layer])
        u = modulate(rmsnorm(x, g_pre_ffn[layer]), sh2, sc2)
        x = x + gt2 * rmsnorm(swiglu(u, w_ffn_in[layer], w_ffn_out[layer]), g_post_ffn[layer])
        if ctx_out:
            h_c = h_c + gt1c * rmsnorm(y_c, g_post_mix[layer])
            uc = modulate(rmsnorm(h_c, g_pre_ffn[layer]), sh2c, sc2c)
            h_c = h_c + gt2c * rmsnorm(swiglu(uc, w_ffn_in[layer], w_ffn_out[layer]), g_post_ffn[layer])
    return x
```

```cpp
#include <hip/hip_runtime.h>
#include <hip/hip_cooperative_groups.h>
#include <cstdio>
namespace cg = cooperative_groups;

typedef unsigned short u16;
using bf16x8 = __attribute__((ext_vector_type(8))) short;
using f32x16 = __attribute__((ext_vector_type(16))) float;
typedef __bf16 bf2_t __attribute__((ext_vector_type(2)));
typedef float f2_t __attribute__((ext_vector_type(2)));
#define DI __device__ __forceinline__
#define MFMA32(a, b, c) __builtin_amdgcn_mfma_f32_32x32x16_bf16((a), (b), (c), 0, 0, 0)

#ifndef PHMASK
#define PHMASK 0xfff
#endif
#ifndef P4SEL
#define P4SEL 3
#endif
#ifndef COOP
#define COOP 1
#endif

constexpr int kD = 1024, kT = 2048, kS = 2304, kNB = 8, kNPASS = 2;
constexpr int kR = kNB * kS;
constexpr int kRL = kNB * kT;
constexpr int kFF = 2816, kINP = 5120;
constexpr int kNITEM = kNB * 36 * 4 * 2;
constexpr float kEPS = 1e-6f;
constexpr float kQSCALE = 0.10206207261596575f * 1.4426950408889634f;
constexpr float kDKS = 0.08838834764831845f;

constexpr size_t al256(size_t x) { return (x + 255) & ~(size_t)255; }
constexpr size_t O_WIN = 0;
constexpr size_t O_WUQ = O_WIN + al256((size_t)kINP * 1024 * 2);
constexpr size_t O_WUKV = O_WUQ + al256((size_t)768 * 512 * 2);
constexpr size_t O_WOMLA = O_WUKV + al256((size_t)1024 * 256 * 2);
constexpr size_t O_WODN = O_WOMLA + al256((size_t)1024 * 512 * 2);
constexpr size_t O_WOUT = O_WODN + al256((size_t)1024 * 512 * 2);
constexpr size_t O_WFFI = O_WOUT + al256((size_t)1024 * 1024 * 2);
constexpr size_t O_WFFO = O_WFFI + al256((size_t)5632 * 1024 * 2);
constexpr size_t O_MOD = O_WFFO + al256((size_t)1024 * 2816 * 2);
constexpr size_t O_ROPE = O_MOD + al256((size_t)17 * 6144 * 4);
constexpr size_t O_PASS = O_ROPE + al256((size_t)2048 * 32 * 4);
constexpr size_t O_U = O_PASS;
constexpr size_t O_CQ = O_U + al256((size_t)kR * 1024 * 2);
constexpr size_t O_CKV = O_CQ + al256((size_t)kRL * 512 * 2);
constexpr size_t O_SM = O_CKV + al256((size_t)kR * 256 * 2);
constexpr size_t O_QKV = O_SM + al256((size_t)kR * 48 * 4);
constexpr size_t O_Z = O_QKV + al256((size_t)kR * 1536 * 2);
constexpr size_t O_GA = O_Z + al256((size_t)kRL * 512 * 2);
constexpr size_t O_GB = O_GA + al256((size_t)kRL * 1024 * 2);
constexpr size_t O_Q = O_GB + al256((size_t)kRL * 1024 * 2);
constexpr size_t O_K = O_Q + al256((size_t)kRL * 768 * 2);
constexpr size_t O_VT = O_K + al256((size_t)kR * 768 * 2);
constexpr size_t O_DN = O_VT + al256((size_t)kR * 512 * 2);
constexpr size_t kDNITEM = 73728;
constexpr size_t O_EDL = O_DN + (size_t)kNITEM * kDNITEM;
constexpr size_t O_BAR = O_EDL + al256((size_t)kNITEM * 4);
constexpr size_t O_END = O_BAR + 16384;
constexpr size_t O_OMLA = O_U;
constexpr size_t O_ODN = O_OMLA + (size_t)kRL * 512 * 2;
static_assert(O_ODN + (size_t)kRL * 512 * 2 <= O_CKV, "alias overflow");
static_assert((size_t)kNB * 32 * 4 * 2 * 32768 == 67108864, "state size");
constexpr size_t O_Y = O_PASS;
constexpr size_t O_U2 = O_Y + (size_t)32768 * 1024 * 2;
constexpr size_t O_H = O_U2 + (size_t)32768 * 1024 * 2;
static_assert(O_H + (size_t)32768 * kFF * 2 <= O_END, "post overflow");
static_assert(O_END <= (size_t)536870912, "workspace overflow");

struct Params {
  const float *x, *c, *ctx, *c_ctx, *w_mod, *b_mod, *g_pre_mix, *g_post_mix, *g_pre_ffn, *g_post_ffn, *w_in,
      *g_q_lora, *w_uq, *g_kv_lora, *w_ukv, *w_o_mla, *conv_qkv, *a_log, *dt_bias, *g_dn_out, *w_o_dn, *w_out,
      *w_ffn_in, *w_ffn_out;
  float* out;
  char* ws;
  int ph_lo, ph_hi;
};

DI int rtid() { int t = __builtin_amdgcn_workitem_id_x(); asm volatile("" : "+v"(t)); return t; }
DI int otid() { return rtid() & 255; }
DI int hid() { return __builtin_amdgcn_readfirstlane(__builtin_amdgcn_workitem_id_x() >> 8); }
DI int vbid() { return blockIdx.x * 2 + hid(); }
DI int vgrid() { return gridDim.x * 2; }
DI size_t ozero() { size_t z = 0; asm volatile("" : "+s"(z)); return z; }
DI unsigned pack2(float a, float b) {
  f2_t v = {a, b};
  bf2_t r = __builtin_convertvector(v, bf2_t);
  return __builtin_bit_cast(unsigned, r);
}
DI u16 f2bf(float a) { return (u16)(pack2(a, 0.f) & 0xffffu); }
DI float bflo(unsigned u) { return __uint_as_float(u << 16); }
DI float bfhi(unsigned u) { return __uint_as_float(u & 0xffff0000u); }
DI float bf2f(u16 v) { return __uint_as_float(((unsigned)v) << 16); }
typedef float nt_f4 __attribute__((ext_vector_type(4)));
typedef unsigned nt_u2 __attribute__((ext_vector_type(2)));
DI float4 ldnt_f4(const float* p) { nt_f4 v = __builtin_nontemporal_load((const nt_f4*)p); return make_float4(v.x, v.y, v.z, v.w); }
DI void stnt_f4(float* p, float4 v) { nt_f4 t = {v.x, v.y, v.z, v.w}; __builtin_nontemporal_store(t, (nt_f4*)p); }
DI uint2 ldnt_u2(const u16* p) { nt_u2 v = __builtin_nontemporal_load((const nt_u2*)p); return make_uint2(v.x, v.y); }
DI void stnt_u2(u16* p, uint2 v) { nt_u2 t = {v.x, v.y}; __builtin_nontemporal_store(t, (nt_u2*)p); }
DI float ldnt_f(const float* p) { return __builtin_nontemporal_load(p); }
DI float sigmoidf_(float x) { return __builtin_amdgcn_rcpf(1.f + __expf(-x)); }
DI float siluf_(float x) { return x * __builtin_amdgcn_rcpf(1.f + __expf(-x)); }
DI float shx(float v, int mask, int lane) {
  return __int_as_float(__builtin_amdgcn_ds_bpermute((lane ^ mask) << 2, __float_as_int(v)));
}
DI float shup(float v, int o, int lane) {
  return __int_as_float(__builtin_amdgcn_ds_bpermute((lane - o) << 2, __float_as_int(v)));
}
DI float wave_sum(float v, int lane) {
#pragma unroll
  for (int o = 32; o >= 1; o >>= 1) v += shx(v, o, lane);
  return v;
}
DI bf16x8 pack8(const f32x16& x, int s) {
  uint4 p;
  p.x = pack2(x[8 * s + 0], x[8 * s + 1]);
  p.y = pack2(x[8 * s + 2], x[8 * s + 3]);
  p.z = pack2(x[8 * s + 4], x[8 * s + 5]);
  p.w = pack2(x[8 * s + 6], x[8 * s + 7]);
  return __builtin_bit_cast(bf16x8, p);
}
DI bf16x8 cat8(uint2 lo, uint2 hi) {
  uint4 p = {lo.x, lo.y, hi.x, hi.y};
  return __builtin_bit_cast(bf16x8, p);
}
DI float bfsel(const uint4& u, int e) {
  const unsigned w = (e >> 1) == 0 ? u.x : ((e >> 1) == 1 ? u.y : ((e >> 1) == 2 ? u.z : u.w));
  return (e & 1) ? bfhi(w) : bflo(w);
}
DI int crow(int i, int h) { return (i & 3) + 8 * (i >> 2) + 4 * h; }


#define XB_TMO      128
#define XB_XCNT(j)  (256  + 64 * (j))
#define XB_XSUB(j)  (1280 + 64 * (j))
#define XB_XGEN(j)  (2304 + 64 * (j))
#define XB_TOP      3328
#define XB_TOPGEN   3392
#define XCD_BAR_WORDS 3456
#define XB_SPIN_CAP (1u << 20)
#define LAS __attribute__((address_space(3)))
DI unsigned xb_ld(unsigned* p) { return __hip_atomic_load(p, __ATOMIC_RELAXED, __HIP_MEMORY_SCOPE_AGENT); }
DI unsigned xb_add(unsigned* p, unsigned v) { return __hip_atomic_fetch_add(p, v, __ATOMIC_RELAXED, __HIP_MEMORY_SCOPE_AGENT); }
DI unsigned xb_xcc_id() { return (unsigned)__builtin_amdgcn_s_getreg((3 << 11) | 20) & 0xFu; }
#define XB_SPIN(cond, bar) do { unsigned _sp = 0; while (cond) { __builtin_amdgcn_s_sleep(1); \
    if ((++_sp & 255u) == 0u) { if (xb_ld(&(bar)[XB_TMO])) break; if (_sp > XB_SPIN_CAP) { atomicAdd(&(bar)[XB_TMO], 1u); break; } } } } while (0)
struct XcdBarrier {
  unsigned* bar;
  unsigned x;
  volatile LAS unsigned* st;
};
DI XcdBarrier xcd_barrier_post(unsigned* bar, volatile LAS unsigned* st) {
  XcdBarrier b;
  b.bar = bar;
  b.x = xb_xcc_id();
  b.st = st;
  if (__builtin_amdgcn_workitem_id_x() == 0) (void)xb_add(&bar[XB_XCNT(b.x)], 1u);
  return b;
}
DI void xcd_barrier_complete(unsigned* bar, unsigned x, unsigned& nloc, unsigned& nx) {
  const unsigned G = gridDim.x * gridDim.y * gridDim.z;
  unsigned sum, cnt, mine, sp = 0u;
  for (;;) {
    sum = 0u; cnt = 0u; mine = 0u;
#pragma unroll
    for (unsigned j = 0; j < 16; ++j) {
      const unsigned c = xb_ld(&bar[XB_XCNT(j)]);
      sum += c;
      cnt += (c > 0u) ? 1u : 0u;
      mine = (j == x) ? c : mine;
    }
    if (sum == G) break;
    __builtin_amdgcn_s_sleep(1);
    if ((++sp & 255u) == 0u) {
      if (xb_ld(&bar[XB_TMO])) break;
      if (sp > XB_SPIN_CAP) { atomicAdd(&bar[XB_TMO], 1u); break; }
    }
  }
  nloc = mine > 0u ? mine : 1u;
  nx = cnt > 0u ? cnt : 1u;
}
DI void xcd_barrier(const XcdBarrier& b) {
  asm volatile("s_waitcnt vmcnt(0)" ::: "memory");
  __syncthreads();
  if (__builtin_amdgcn_workitem_id_x() == 0) {
    typedef __attribute__((address_space(1))) unsigned gu32_t;
    gu32_t* gb_ = (gu32_t*)b.bar;
    asm volatile("" : "+s"(gb_));
    unsigned* bar = (unsigned*)gb_;
    __builtin_amdgcn_s_waitcnt(0);
    unsigned nloc = b.st[0], nx = b.st[1];
    if (nloc == 0u) { xcd_barrier_complete(bar, b.x, nloc, nx); b.st[0] = nloc; b.st[1] = nx; }
    const unsigned old = xb_add(&bar[XB_XSUB(b.x)], 1u);
    const unsigned gen = old / nloc;
    if (old + 1u == (gen + 1u) * nloc) {
      __builtin_amdgcn_fence(__ATOMIC_RELEASE, "agent");
      asm volatile("s_waitcnt vmcnt(0)" ::: "memory");
      const unsigned og = xb_add(&bar[XB_TOP], 1u);
      const unsigned tg = og / nx;
      if (og + 1u == (tg + 1u) * nx) xb_add(&bar[XB_TOPGEN], 1u);
      else XB_SPIN(xb_ld(&bar[XB_TOPGEN]) == tg, bar);
      __builtin_amdgcn_fence(__ATOMIC_ACQUIRE, "agent");
      xb_add(&bar[XB_XGEN(b.x)], 1u);
      asm volatile("s_waitcnt vmcnt(0)" ::: "memory");
    } else {
      XB_SPIN(xb_ld(&bar[XB_XGEN(b.x)]) == gen, bar);
      __builtin_amdgcn_fence(__ATOMIC_ACQUIRE, "agent");
      asm volatile("s_waitcnt vmcnt(0)" ::: "memory");
    }
  }
  __syncthreads();
}

using f32x4 = __attribute__((ext_vector_type(4))) float;
#define MFMA16(a, b, c) __builtin_amdgcn_mfma_f32_16x16x32_bf16((a), (b), (c), 0, 0, 0)
DI void stage_rc2(int b, int& R, int& C) {
  const int st = b >> 10, sb = b & 1023, swz = sb ^ (((sb >> 9) & 1) << 5);
  R = (st >> 1) * 16 + (swz >> 6);
  C = (st & 1) * 32 + ((swz & 63) >> 1);
}
template <bool SS>
DI void gemm256(f32x4 (&acc)[8][4], const u16* __restrict__ Ab, const u16* __restrict__ Bb, int K, char* shm,
                float (&ss)[8]) {
  const int tid = rtid(), wid = tid >> 6, lane = tid & 63, wr = wid >> 2, wc = wid & 3, fr = lane & 15, fq = lane >> 4;
  int o0;
  {
    int R, C;
    stage_rc2(wid * 1024 + lane * 16, R, C);
    o0 = R * K + C;
  }
  const int o1 = o0 + 64 * K, o2 = o0 + 128 * K, o3 = o0 + 192 * K;
  const int wo = wid * 1024 + lane * 16;
  const int lanepart = (fr * 64 + fq * 16) ^ ((fr >> 3) << 5);
  uint4 sa0, sa1, sa2, sa3, sb0, sb1, sb2, sb3;
#define G_ISSUE(kt)                                        \
  do {                                                     \
    const int ko_ = (kt) * 64;                             \
    sa0 = *(const uint4*)(Ab + o0 + ko_);                  \
    sb0 = *(const uint4*)(Bb + o0 + ko_);                  \
    sa1 = *(const uint4*)(Ab + o1 + ko_);                  \
    sb1 = *(const uint4*)(Bb + o1 + ko_);                  \
    sa2 = *(const uint4*)(Ab + o2 + ko_);                  \
    sb2 = *(const uint4*)(Bb + o2 + ko_);                  \
    sa3 = *(const uint4*)(Ab + o3 + ko_);                  \
    sb3 = *(const uint4*)(Bb + o3 + ko_);                  \
  } while (0)
#define G_WRITE(buf)                                       \
  do {                                                     \
    char* a_ = shm + (buf) * 65536 + wo;                   \
    *(uint4*)(a_) = sa0;                                   \
    *(uint4*)(a_ + 32768) = sb0;                           \
    *(uint4*)(a_ + 8192) = sa1;                            \
    *(uint4*)(a_ + 32768 + 8192) = sb1;                    \
    *(uint4*)(a_ + 16384) = sa2;                           \
    *(uint4*)(a_ + 32768 + 16384) = sb2;                   \
    *(uint4*)(a_ + 24576) = sa3;                           \
    *(uint4*)(a_ + 32768 + 24576) = sb3;                   \
  } while (0)
  const int nt = K >> 6;
  G_ISSUE(0);
  __syncthreads();
  G_WRITE(0);
  G_ISSUE(1);
  __syncthreads();
  for (int t = 0; t < nt; ++t) {
    const int cur = t & 1;
    if (t + 1 < nt) G_WRITE(cur ^ 1);
    if (t + 2 < nt) G_ISSUE(t + 2);
    const char* sAp = shm + cur * 65536 + wr * 16384 + lanepart;
    const char* sBp = shm + cur * 65536 + 32768 + wc * 8192 + lanepart;
#pragma unroll
    for (int ks = 0; ks < 2; ++ks) {
      bf16x8 Bf[4];
#pragma unroll
      for (int n = 0; n < 4; ++n) Bf[n] = *(const bf16x8*)(sBp + n * 2048 + ks * 1024);
#pragma unroll
      for (int mh = 0; mh < 2; ++mh) {
        bf16x8 At[4];
#pragma unroll
        for (int m = 0; m < 4; ++m) At[m] = *(const bf16x8*)(sAp + (mh * 4 + m) * 2048 + ks * 1024);
#pragma unroll
        for (int m = 0; m < 4; ++m)
#pragma unroll
          for (int n = 0; n < 4; ++n) acc[mh * 4 + m][n] = MFMA16(Bf[n], At[m], acc[mh * 4 + m][n]);
      }
    }
    __syncthreads();
  }
#undef G_ISSUE
#undef G_WRITE
}
DI float sq8(const uint4 u) {
  return bflo(u.x) * bflo(u.x) + bfhi(u.x) * bfhi(u.x) + bflo(u.y) * bflo(u.y) + bfhi(u.y) * bfhi(u.y) +
         bflo(u.z) * bflo(u.z) + bfhi(u.z) * bfhi(u.z) + bflo(u.w) * bflo(u.w) + bfhi(u.w) * bfhi(u.w);
}
DI void row_rstd256(const u16* __restrict__ A, int K, float* rs) {
  const int tid = rtid(), wid = tid >> 6, lane = tid & 63;
  __syncthreads();
  if (K == 512) {
#pragma unroll 1
    for (int b0 = 0; b0 < 32; b0 += 8) {
      uint4 u[8];
#pragma unroll
      for (int i = 0; i < 8; ++i) u[i] = *(const uint4*)(A + (size_t)(wid * 32 + b0 + i) * 512 + lane * 8);
#pragma unroll
      for (int i = 0; i < 8; ++i) {
        const float s = wave_sum(sq8(u[i]), lane);
        if (lane == 0) rs[wid * 32 + b0 + i] = rsqrtf(s * (1.f / 512.f) + kEPS);
      }
    }
  } else {
#pragma unroll 1
    for (int b0 = 0; b0 < 32; b0 += 16) {
      uint4 u[8];
#pragma unroll
      for (int i = 0; i < 8; ++i) u[i] = *(const uint4*)(A + (size_t)(wid * 32 + b0 + 2 * i + (lane >> 5)) * 256 + (lane & 31) * 8);
#pragma unroll
      for (int i = 0; i < 8; ++i) {
        float s = sq8(u[i]);
        s += shx(s, 1, lane); s += shx(s, 2, lane); s += shx(s, 4, lane); s += shx(s, 8, lane); s += shx(s, 16, lane);
        if ((lane & 31) == 0) rs[wid * 32 + b0 + 2 * i + (lane >> 5)] = rsqrtf(s * (1.f / 256.f) + kEPS);
      }
    }
  }
}
#define MEMFENCE() asm volatile("" ::: "memory")
DI void zero_acc(f32x4 (&acc)[8][4]) {
#pragma unroll
  for (int m = 0; m < 8; ++m)
#pragma unroll
    for (int n = 0; n < 4; ++n)
#pragma unroll
      for (int j = 0; j < 4; ++j) acc[m][n][j] = 0.f;
}
#define FOR_FRAG(m, n) _Pragma("unroll") for (int m = 0; m < 8; ++m) _Pragma("unroll") for (int n = 0; n < 4; ++n)

DI bool tile_of(int q, int nrt, int nct, int nranks, int scols, int& rt, int& ct, bool& done) {
  const int b = blockIdx.x;
  const int xcd = b & 7, rank = b >> 3;
  done = false;
  if (rank >= nranks) { done = true; return false; }
  const int srows = nranks / scols;
  const int nsc = (nct + scols - 1) / scols, nsr = (nrt + srows - 1) / srows;
  const int st = q * 8 + xcd;
  if (st >= nsr * nsc) { done = true; return false; }
  rt = (st / nsc) * srows + rank / scols;
  ct = (st % nsc) * scols + rank % scols;
  return rt < nrt && ct < nct && rank < srows * scols;
}
#define FOR_TILES_N(nrt, nct, nranks, scols, rt, ct)                   \
  for (int q_ = 0, rt = 0, ct = 0;; ++q_)                              \
    if (bool done_ = false; !tile_of(q_, (nrt), (nct), (nranks), (scols), rt, ct, done_)) { \
      if (done_) break;                                                \
    } else
DI int tile_scols(int nranks) { return (nranks & 3) == 0 ? 4 : 1; }
#define FOR_TILES(nrt, nct, rt, ct) FOR_TILES_N(nrt, nct, (gridDim.x >> 3), tile_scols(gridDim.x >> 3), rt, ct)

DI int colmap(int mode, int n) {
  if (mode == 0) return n;
  if (mode == 1) {
    if (n < 768) return n;
    if (n < 896) {
      int j = n - 768;
      if (j < 32) return 768 + j;
      if (j < 40) return 2848 + (j - 32);
      if (j < 48) return 2856 + (j - 40);
      return -1;
    }
    if (n < 2432) return 800 + (n - 896);
    if (n < 2944) return 2336 + (n - 2432);
    if (n < 4992) return 2864 + (n - 2944);
    return -1;
  }
  int blk = n >> 4, w = n & 15;
  return (blk & 1) * kFF + (blk >> 1) * 16 + w;
}
DI void conv_tile(const float* __restrict__ src, int K, int Nsrc, u16* __restrict__ dst, int mode,
                  const float* __restrict__ scale, int smask, int tk, int tn, float* tile  ) {
  const int tid = otid();
  const int k0 = tk * 64, n0 = tn * 64;
  __syncthreads();
  {
    const int nn = tid & 63;
    const int sc = colmap(mode, n0 + nn);
#pragma unroll 4
    for (int i = 0; i < 16; ++i) {
      const int kk = (tid >> 6) + 4 * i;
      float v = 0.f;
      if (sc >= 0) v = ldnt_f(src + (size_t)(k0 + kk) * Nsrc + sc);
      if (scale) v *= scale[(k0 + kk) & smask];
      tile[kk * 65 + nn] = v;
    }
  }
  __syncthreads();
  {
    const int kk8 = (tid & 7) * 8;
#pragma unroll
    for (int i = 0; i < 2; ++i) {
      const int nn = (tid >> 3) + 32 * i;
      uint4 o;
      o.x = pack2(tile[(kk8 + 0) * 65 + nn], tile[(kk8 + 1) * 65 + nn]);
      o.y = pack2(tile[(kk8 + 2) * 65 + nn], tile[(kk8 + 3) * 65 + nn]);
      o.z = pack2(tile[(kk8 + 4) * 65 + nn], tile[(kk8 + 5) * 65 + nn]);
      o.w = pack2(tile[(kk8 + 6) * 65 + nn], tile[(kk8 + 7) * 65 + nn]);
      *(uint4*)(dst + (size_t)(n0 + nn) * K + k0 + kk8) = o;
    }
  }
}
DI void phase0(const Params& p, char* smem) {
  const int tid = otid();
  const int NT0 = 16 * 80, NT1 = 8 * 12, NT2 = 4 * 16, NT3 = 8 * 16, NT4 = 8 * 16, NT5 = 16 * 16, NT6 = 16 * 88,
            NT7 = 44 * 16;
  const int nconv = NT0 + NT1 + NT2 + NT3 + NT4 + NT5 + NT6 + NT7;
  const int nwork = 192 + 128 + nconv;
  for (int w2 = blockIdx.x; w2 < nwork / 2; w2 += gridDim.x) {
    const int w = 2 * w2 + hid();
    if (w < 192) {
      float* cs = (float*)smem;
      float* red = cs + 17 * 512;
      const int n0 = w * 32, nn = tid & 31, kg = tid >> 5;
      float a[17];
#pragma unroll
      for (int b = 0; b < 17; ++b) a[b] = 0.f;
      for (int half = 0; half < 2; ++half) {
        __syncthreads();
        for (int idx = tid; idx < 17 * 512; idx += 256) {
          int b = idx >> 9, kk = idx & 511, k = half * 512 + kk;
          float v = b < 16 ? p.c[b * 1024 + k] : p.c_ctx[k];
          cs[idx] = v / (1.f + expf(-v));
        }
        __syncthreads();
        for (int kk = kg * 64; kk < kg * 64 + 64; ++kk) {
          float wv = ldnt_f(p.w_mod + (size_t)(half * 512 + kk) * 6144 + n0 + nn);
#pragma unroll
          for (int b = 0; b < 17; ++b) a[b] += cs[b * 512 + kk] * wv;
        }
      }
#pragma unroll
      for (int b = 0; b < 17; ++b) red[(kg * 17 + b) * 32 + nn] = a[b];
      __syncthreads();
      float* mod = (float*)(p.ws + O_MOD);
      for (int idx = tid; idx < 17 * 32; idx += 256) {
        int b = idx >> 5, n = idx & 31;
        float s = p.b_mod[n0 + n];
#pragma unroll
        for (int g = 0; g < 8; ++g) s += red[(g * 17 + b) * 32 + n];
        mod[b * 6144 + n0 + n] = s;
      }
      __syncthreads();
    } else if (w < 320) {
      float* rc = (float*)(p.ws + O_ROPE);
      float* rs = rc + 2048 * 16;
      int idx = (w - 192) * 256 + tid;
      int pos = idx >> 4, j = idx & 15, axis = j >> 3, f = j & 7;
      float inv = powf(10000.f, -(float)f / 8.f);
      float coord = (float)(axis == 0 ? (pos >> 6) : (pos & 63));
      float sn, cs;
      sincosf(coord * inv, &sn, &cs);
      rc[idx] = cs;
      rs[idx] = sn;
    } else {
      int t = w - 320;
      float* tile = (float*)smem;
      if (t < NT0) { conv_tile(p.w_in, 1024, 4912, (u16*)(p.ws + O_WIN), 1, nullptr, 0, t % 16, t / 16, tile); continue; }
      t -= NT0;
      if (t < NT1) { conv_tile(p.w_uq, 512, 768, (u16*)(p.ws + O_WUQ), 0, p.g_q_lora, 0xffff, t % 8, t / 8, tile); continue; }
      t -= NT1;
      if (t < NT2) { conv_tile(p.w_ukv, 256, 1024, (u16*)(p.ws + O_WUKV), 0, p.g_kv_lora, 0xffff, t % 4, t / 4, tile); continue; }
      t -= NT2;
      if (t < NT3) { conv_tile(p.w_o_mla, 512, 1024, (u16*)(p.ws + O_WOMLA), 0, nullptr, 0, t % 8, t / 8, tile); continue; }
      t -= NT3;
      if (t < NT4) { conv_tile(p.w_o_dn, 512, 1024, (u16*)(p.ws + O_WODN), 0, p.g_dn_out, 127, t % 8, t / 8, tile); continue; }
      t -= NT4;
      if (t < NT5) { conv_tile(p.w_out, 1024, 1024, (u16*)(p.ws + O_WOUT), 0, nullptr, 0, t % 16, t / 16, tile); continue; }
      t -= NT5;
      if (t < NT6) { conv_tile(p.w_ffn_in, 1024, 2 * kFF, (u16*)(p.ws + O_WFFI), 2, nullptr, 0, t % 16, t / 16, tile); continue; }
      t -= NT6;
      conv_tile(p.w_ffn_out, kFF, 1024, (u16*)(p.ws + O_WFFO), 0, nullptr, 0, t % 44, t / 44, tile);
    }
  }
}

DI void phase1(const Params& p, int pass) {
  const int tid_ = rtid(); const int lane = tid_ & 63, wv = tid_ >> 6;
  const float* mod = (const float*)(p.ws + O_MOD);
  u16* U = (u16*)(p.ws + O_U);
  for (int row = blockIdx.x * 8 + wv; row < kR; row += gridDim.x * 8) {
    const int bl = row / kS, pos = row % kS, b = pass * kNB + bl;
    const float* src = pos < kT ? p.x + ((size_t)b * kT + pos) * kD : p.ctx + ((size_t)b * 256 + (pos - kT)) * kD;
    const float* md = mod + (pos < kT ? b : 16) * 6144;
    float4 v[4];
    float ss = 0.f;
#pragma unroll
    for (int i = 0; i < 4; ++i) {
      v[i] = ldnt_f4(src + i * 256 + lane * 4);
      ss += v[i].x * v[i].x + v[i].y * v[i].y + v[i].z * v[i].z + v[i].w * v[i].w;
    }
    ss = wave_sum(ss, lane);
    const float rstd = rsqrtf(ss * (1.f / 1024.f) + kEPS);
#pragma unroll
    for (int i = 0; i < 4; ++i) {
      const int k = i * 256 + lane * 4;
      float4 g = *(const float4*)(p.g_pre_mix + k), sh = *(const float4*)(md + k), sc = *(const float4*)(md + 1024 + k);
      uint2 o;
      o.x = pack2(v[i].x * rstd * g.x * (1.f + sc.x) + sh.x, v[i].y * rstd * g.y * (1.f + sc.y) + sh.y);
      o.y = pack2(v[i].z * rstd * g.z * (1.f + sc.z) + sh.z, v[i].w * rstd * g.w * (1.f + sc.w) + sh.w);
      *(uint2*)(U + (size_t)row * kD + k) = o;
    }
  }
}

DI void phase2(const Params& p, char* smem) {
  const u16* U = (const u16*)(p.ws + O_U);
  const u16* W = (const u16*)(p.ws + O_WIN);
  FOR_TILES(72, 20, rt, ct) {
    const int bl = rt / 9, tt = rt % 9;
    const bool isctx = tt == 8;
    if (isctx && !(ct >= 2 && ct <= 9)) continue;
    f32x4 acc[8][4];
    zero_acc(acc);
    float ss[8];
    gemm256<false>(acc, U + (size_t)rt * 256 * kD, W + (size_t)ct * 256 * kD, kD, smem, ss);
    const int tid = rtid(), wid = tid >> 6, lane = tid & 63, wr = wid >> 2, wc = wid & 3, fr = lane & 15, fq = lane >> 4;

    const int seg = ct * 2 + (wc >> 1);
    if (seg == 39 || (isctx && !(seg >= 4 && seg < 19))) continue;
    const int grow0 = rt * 256 + wr * 128 + fr;
    const int lrow0 = bl * kT + tt * 256 + wr * 128 + fr;
    const int cs0 = (wc & 1) * 64 + fq * 4;
    if (seg == 6) {
      float* SM = (float*)(p.ws + O_SM);
      FOR_FRAG(m, n) {
        const int col = cs0 + n * 16;
        if (col < 48) *(float4*)(SM + (size_t)(grow0 + m * 16) * 48 + col) = make_float4(acc[m][n][0], acc[m][n][1], acc[m][n][2], acc[m][n][3]);
      }
    } else {
      u16* dst;
      int ld, row0, c0;
      if (seg < 4) { dst = (u16*)(p.ws + O_CQ); ld = 512; row0 = lrow0; c0 = seg * 128; }
      else if (seg < 6) { dst = (u16*)(p.ws + O_CKV); ld = 256; row0 = grow0; c0 = (seg - 4) * 128; }
      else if (seg < 19) { dst = (u16*)(p.ws + O_QKV); ld = 1536; row0 = grow0; c0 = (seg - 7) * 128; }
      else if (seg < 23) { dst = (u16*)(p.ws + O_Z); ld = 512; row0 = lrow0; c0 = (seg - 19) * 128; }
      else if (seg < 31) { dst = (u16*)(p.ws + O_GA); ld = 1024; row0 = lrow0; c0 = (seg - 23) * 128; }
      else { dst = (u16*)(p.ws + O_GB); ld = 1024; row0 = lrow0; c0 = (seg - 31) * 128; }
      if (seg >= 19) {
        FOR_FRAG(m, n) {
          const uint2 o = {pack2(acc[m][n][0], acc[m][n][1]), pack2(acc[m][n][2], acc[m][n][3])};
          stnt_u2(dst + (size_t)(row0 + m * 16) * ld + c0 + cs0 + n * 16, o);
        }
      } else {
        FOR_FRAG(m, n) {
          const uint2 o = {pack2(acc[m][n][0], acc[m][n][1]), pack2(acc[m][n][2], acc[m][n][3])};
          *(uint2*)(dst + (size_t)(row0 + m * 16) * ld + c0 + cs0 + n * 16) = o;
        }
      }
    }
  }
}

DI void dn_intra(const Params& p, int item, char* smem) {
  const int tid = otid(), lane = tid & 63, wid = tid >> 6, r = lane & 31, h = lane >> 5;
  const int dir = item & 1, hd = (item >> 1) & 3, c = (item >> 3) % 36, bl = (item >> 3) / 36;
  const bool latent = c < 32;
  const int seq_lo = latent ? 0 : kT, seq_hi = latent ? kT : kS;
  const int base = c * 64;
  const size_t rowbase = (size_t)bl * kS;
  u16* Ks = (u16*)smem;
  u16* Qs = Ks + 64 * 136;
  u16* Vs = Qs + 64 * 136;
  float* L = (float*)Qs;
  float* gcs = (float*)(Vs + 64 * 136);
  float* bts = gcs + 64;
  float* sclk = bts + 64;
  const float* SM = (const float*)(p.ws + O_SM);
  const u16* QKV = (const u16*)(p.ws + O_QKV);
  char* ib = p.ws + O_DN + (size_t)item * kDNITEM;
  u16* UdT = (u16*)ib;
  u16* Wd = (u16*)(ib + 16384);
  u16* KdT = (u16*)(ib + 32768);
  u16* Qg = (u16*)(ib + 49152);
  u16* QKd = (u16*)(ib + 65536);
  __syncthreads();
  float* cwS = sclk + 64 + 48 * 64;
  for (int x = tid; x < 288; x += 256) {
    const int j = x / 96, q = x % 96;
    *(float4*)(cwS + j * 384 + q * 4) = *(const float4*)(p.conv_qkv + j * 1536 + (q >> 5) * 512 + hd * 128 + (q & 31) * 4);
  }
  if (wid == 0) {
    const int pos = base + (dir ? 63 - lane : lane);
    const float* smr = SM + (rowbase + pos) * 48;
    const float beta = sigmoidf_(smr[32 + dir * 4 + hd]);
    const float al = smr[40 + dir * 4 + hd] + p.dt_bias[dir * 4 + hd];
    const float te = __expf(al);
    const float sp = al > 15.f ? al : (te < 0.01f ? te * (1.f - te * (0.5f - te * (1.f / 3.f))) : __logf(1.f + te));
    float g = -__expf(p.a_log[dir * 4 + hd]) * sp;
#pragma unroll
    for (int o = 1; o < 64; o <<= 1) {
      float t = shup(g, o, lane);
      if (lane >= o) g += t;
    }
    gcs[lane] = g;
    bts[lane] = beta;
    sclk[lane] = beta * __expf(g);
  }
  __syncthreads();
  {
    const int hf = hid();
    char* sm0 = smem - hf * 73728;
    char* ib0 = p.ws + O_DN + (size_t)(item & ~1) * kDNITEM;
    uint4 U0[6], U1[6], U2[6];
#pragma unroll
    for (int k = 0; k < 6; ++k) {
      const int idx = hf * 1536 + k * 256 + tid;
      const int i = idx / 48, cg_ = idx % 48, seg = cg_ >> 4, cc = (cg_ & 15) * 8;
      const int pos = base + i;
      const u16* rp = QKV + (rowbase + pos) * 1536 + seg * 512 + hd * 128 + cc;
      U1[k] = *(const uint4*)rp;
      U0[k] = make_uint4(0, 0, 0, 0);
      U2[k] = make_uint4(0, 0, 0, 0);
      if (pos - 1 >= seq_lo) U0[k] = *(const uint4*)(rp - 1536);
      if (pos + 1 < seq_hi) U2[k] = *(const uint4*)(rp + 1536);
    }
#pragma unroll
    for (int k = 0; k < 6; ++k) {
      const int idx = hf * 1536 + k * 256 + tid;
      const int i = idx / 48, cg_ = idx % 48, seg = cg_ >> 4, cc = (cg_ & 15) * 8;
      const float* cw = cwS + seg * 128 + cc;
      float w0[8], w1[8], w2[8];
      *(float4*)&w0[0] = *(const float4*)(cw);        *(float4*)&w0[4] = *(const float4*)(cw + 4);
      *(float4*)&w1[0] = *(const float4*)(cw + 384);  *(float4*)&w1[4] = *(const float4*)(cw + 388);
      *(float4*)&w2[0] = *(const float4*)(cw + 768);  *(float4*)&w2[4] = *(const float4*)(cw + 772);
      float v[8];
      float ssq = 0.f;
#pragma unroll
      for (int e = 0; e < 8; ++e) {
        const float x0 = bfsel(U0[k], e), x1 = bfsel(U1[k], e), x2 = bfsel(U2[k], e);
        float cv = x0 * w0[e] + x1 * w1[e] + x2 * w2[e];
        cv = siluf_(cv);
        v[e] = cv;
        ssq += cv * cv;
      }
      ssq += shx(ssq, 8, lane);
      ssq += shx(ssq, 4, lane);
      ssq += shx(ssq, 2, lane);
      ssq += shx(ssq, 1, lane);
      const float sc = seg < 2 ? rsqrtf(ssq + kEPS) : 1.f;
#pragma unroll
      for (int e = 0; e < 8; ++e) v[e] *= sc;
      const uint4 o = {pack2(v[0], v[1]), pack2(v[2], v[3]), pack2(v[4], v[5]), pack2(v[6], v[7])};
      const int tofs = (seg == 0 ? 64 * 136 : (seg == 1 ? 0 : 2 * 64 * 136));
#pragma unroll
      for (int d = 0; d < 2; ++d) {
        const int rowd = d ? 63 - i : i;
        char* smd = sm0 + d * 73728;
        *(uint4*)((u16*)smd + tofs + rowd * 136 + cc) = o;
        if (seg == 0 && latent) {
          const float qs = __expf(((const float*)(smd + 52224))[rowd]) * kDKS;
          const uint4 o2 = {pack2(v[0] * qs, v[1] * qs), pack2(v[2] * qs, v[3] * qs), pack2(v[4] * qs, v[5] * qs),
                            pack2(v[6] * qs, v[7] * qs)};
          *(uint4*)((u16*)(ib0 + (size_t)d * kDNITEM + 49152) + rowd * 128 + cc) = o2;
        }
      }
    }
  }
  __syncthreads();
  const int bi = wid >> 1, bj = wid & 1;
  f32x16 akk, aqk;
#pragma unroll
  for (int i = 0; i < 16; ++i) { akk[i] = 0.f; aqk[i] = 0.f; }
#pragma unroll
  for (int ks = 0; ks < 8; ++ks) {
    bf16x8 ak = *(const bf16x8*)(Ks + (bi * 32 + r) * 136 + ks * 16 + h * 8);
    bf16x8 aq = *(const bf16x8*)(Qs + (bi * 32 + r) * 136 + ks * 16 + h * 8);
    bf16x8 bk = *(const bf16x8*)(Ks + (bj * 32 + r) * 136 + ks * 16 + h * 8);
    akk = MFMA32(ak, bk, akk);
    aqk = MFMA32(aq, bk, aqk);
  }
  __syncthreads();
  {
    const int col = bj * 32 + r;
    const float gcc = gcs[col];
#pragma unroll
    for (int i = 0; i < 16; ++i) {
      const int row = bi * 32 + crow(i, h);
      const float gr = gcs[row];
      const float dec = __expf(fminf(gr - gcc, 0.f));
      L[row * 64 + col] = row > col ? akk[i] * bts[row] * dec : 0.f;
      if (latent) QKd[row * 64 + col] = f2bf(row >= col ? aqk[i] * kDKS * dec : 0.f);
    }
  }
  __syncthreads();
  {
    const int widu = __builtin_amdgcn_readfirstlane(wid);
    float* Tf = sclk + 64;
    float* Pw = Tf + 4096 + widu * 256;
    for (int x = tid; x < 6 * 256; x += 256) {
      const int blk = x >> 8, e = x & 255;
      const int I = blk < 3 ? 0 : (blk < 5 ? 1 : 2), J = blk < 3 ? blk + 1 : (blk < 5 ? blk - 1 : 3);
      Tf[(16 * I + (e >> 4)) * 64 + 16 * J + (e & 15)] = 0.f;
    }
    {
      const int c = lane & 15, I = widu;
      float lrow[16], acc[16];
#pragma unroll
      for (int ii = 0; ii < 16; ++ii) {
        lrow[ii] = L[(16 * I + ii) * 64 + 16 * I + c];
        acc[ii] = (ii == c) ? 1.f : 0.f;
      }
#pragma unroll
      for (int ii = 1; ii < 16; ++ii)
#pragma unroll
        for (int j = 0; j < ii; ++j)
          acc[ii] -= __int_as_float(__builtin_amdgcn_readlane(__float_as_int(lrow[ii]), j)) * acc[j];
      if (lane < 16) {
#pragma unroll
        for (int ii = 0; ii < 16; ++ii) Tf[(16 * I + ii) * 64 + 16 * I + c] = acc[ii];
      }
    }
    __syncthreads();
    const int l15 = lane & 15, l4 = lane >> 4;
#define MM16(accv, Ap, lda, Bp, ldb)                                                                   \
  _Pragma("unroll") for (int kk = 0; kk < 4; ++kk)                                                     \
    accv = __builtin_amdgcn_mfma_f32_16x16x4f32((Ap)[l15 * (lda) + 4 * kk + l4], (Bp)[(4 * kk + l4) * (ldb) + l15], accv, 0, 0, 0)
#define SOLVE_BLOCK(I, J)                                                                              \
  do {                                                                                                 \
    f32x4 P_ = {0.f, 0.f, 0.f, 0.f};                                                                   \
    for (int K_ = (J); K_ < (I); ++K_) MM16(P_, L + (16 * (I)) * 64 + 16 * K_, 64, Tf + (16 * K_) * 64 + 16 * (J), 64); \
    _Pragma("unroll") for (int i = 0; i < 4; ++i) Pw[(4 * l4 + i) * 16 + l15] = P_[i];                 \
    f32x4 R_ = {0.f, 0.f, 0.f, 0.f};                                                                   \
    MM16(R_, Tf + (16 * (I)) * 64 + 16 * (I), 64, Pw, 16);                                             \
    _Pragma("unroll") for (int i = 0; i < 4; ++i) Tf[(16 * (I) + 4 * l4 + i) * 64 + 16 * (J) + l15] = -R_[i]; \
  } while (0)
    if (widu < 3) SOLVE_BLOCK(widu + 1, widu);
    __syncthreads();
    if (widu < 2) SOLVE_BLOCK(widu + 2, widu);
    __syncthreads();
    if (widu == 0) SOLVE_BLOCK(3, 0);
    __syncthreads();
#undef SOLVE_BLOCK
#undef MM16
    u16* Tl = (u16*)L;
    for (int x = tid; x < 4096; x += 256) {
      const int i = x >> 6, c = x & 63;
      const float t = Tf[i * 64 + c];
      Tl[i * 128 + c] = f2bf(t * bts[c]);
      Tl[i * 128 + 64 + c] = f2bf(t * sclk[c]);
    }
  }
  __syncthreads();
  {
    const u16* Tl = (const u16*)L;
    const int cb = wid * 32;
    f32x16 au[2], aw[2];
#pragma unroll
    for (int m = 0; m < 2; ++m)
#pragma unroll
      for (int i = 0; i < 16; ++i) { au[m][i] = 0.f; aw[m][i] = 0.f; }
#pragma unroll
    for (int s = 0; s < 4; ++s) {
      bf16x8 bv, ak;
#pragma unroll
      for (int jj = 0; jj < 8; ++jj) {
        bv[jj] = (short)Vs[(16 * s + 8 * h + jj) * 136 + cb + r];
        ak[jj] = (short)Ks[(16 * s + 8 * h + jj) * 136 + cb + r];
      }
#pragma unroll
      for (int m = 0; m < 2; ++m) {
        const bf16x8 tv = *(const bf16x8*)(Tl + (32 * m + r) * 128 + 16 * s + 8 * h);
        const bf16x8 tk = *(const bf16x8*)(Tl + (32 * m + r) * 128 + 64 + 16 * s + 8 * h);
        au[m] = MFMA32(tv, bv, au[m]);
        aw[m] = MFMA32(ak, tk, aw[m]);
      }
    }
#pragma unroll
    for (int m = 0; m < 2; ++m)
#pragma unroll
      for (int g = 0; g < 4; ++g) {
        uint2 ou = {pack2(au[m][4 * g], au[m][4 * g + 1]), pack2(au[m][4 * g + 2], au[m][4 * g + 3])};
        *(uint2*)(UdT + (cb + r) * 64 + 32 * m + 8 * g + 4 * h) = ou;
        uint2 ow = {pack2(-aw[m][4 * g], -aw[m][4 * g + 1]), pack2(-aw[m][4 * g + 2], -aw[m][4 * g + 3])};
        *(uint2*)(Wd + (32 * m + r) * 128 + cb + 8 * g + 4 * h) = ow;
      }
  }
  {
    const int dk = tid & 127, ih = tid >> 7;
    const float gl = gcs[63];
#pragma unroll
    for (int q = 0; q < 4; ++q) {
      float t[8];
#pragma unroll
      for (int e = 0; e < 8; ++e) {
        const int i = ih * 32 + q * 8 + e;
        t[e] = bf2f(Ks[i * 136 + dk]) * __expf(gl - gcs[i]);
      }
      uint4 o = {pack2(t[0], t[1]), pack2(t[2], t[3]), pack2(t[4], t[5]), pack2(t[6], t[7])};
      *(uint4*)(KdT + dk * 64 + ih * 32 + q * 8) = o;
    }
    if (tid == 0) ((float*)(p.ws + O_EDL))[item] = __expf(gl);
  }
}

DI void qproj_tile(const Params& p, int rt, int ct, char* smem) {
  f32x4 acc[8][4];
  zero_acc(acc);
  float ss[8];
  float* rs = (float*)(smem + 131072);
  row_rstd256((const u16*)(p.ws + O_CQ) + (size_t)rt * 256 * 512, 512, rs);
  gemm256<false>(acc, (const u16*)(p.ws + O_CQ) + (size_t)rt * 256 * 512, (const u16*)(p.ws + O_WUQ) + (size_t)ct * 256 * 512,
                 512, smem, ss);
    const int tid = rtid(), wid = tid >> 6, lane = tid & 63, wr = wid >> 2, wc = wid & 3, fr = lane & 15, fq = lane >> 4;

  const float* rc = (const float*)(p.ws + O_ROPE);
  const float* rsn = rc + 2048 * 16;
  u16* Q = (u16*)(p.ws + O_Q);
#pragma unroll
  for (int m = 0; m < 8; ++m) {
    MEMFENCE();
    const float rstd = rs[wr * 128 + m * 16 + fr];
    const int lrow = rt * 256 + wr * 128 + m * 16 + fr;
    const int t = lrow & (kT - 1), bl = lrow >> 11;
#pragma unroll
    for (int n = 0; n < 4; ++n) {
      const int gc = ct * 256 + wc * 64 + n * 16 + fq * 4;
      const int hq = gc / 96, d = gc % 96;
      float v[4];
#pragma unroll
      for (int j = 0; j < 4; ++j) v[j] = acc[m][n][j] * rstd;
      if (((ct * 256 + wc * 64 + n * 16) % 96) >= 64) {
        float pv[4];
#pragma unroll
        for (int j = 0; j < 4; ++j) pv[j] = shx(v[j], 32, lane);
        const int e0 = d - 64;
        const int axis = e0 >> 4, upper = (e0 >> 3) & 1;
        const float4 cs4 = *(const float4*)(rc + t * 16 + axis * 8 + (e0 & 7));
        const float4 sn4 = *(const float4*)(rsn + t * 16 + axis * 8 + (e0 & 7));
        const float csv[4] = {cs4.x, cs4.y, cs4.z, cs4.w}, snv[4] = {sn4.x, sn4.y, sn4.z, sn4.w};
#pragma unroll
        for (int j = 0; j < 4; ++j) v[j] = upper ? (pv[j] * snv[j] + v[j] * csv[j]) : (v[j] * csv[j] - pv[j] * snv[j]);
      }
      const uint2 o = {pack2(v[0] * kQSCALE, v[1] * kQSCALE), pack2(v[2] * kQSCALE, v[3] * kQSCALE)};
      *(uint2*)(Q + (((size_t)bl * 8 + hq) * kT + t) * 96 + d) = o;
    }
  }
}
DI void kvproj_tile(const Params& p, int rt, int ct, char* smem) {
  f32x4 acc[8][4];
  zero_acc(acc);
  float ss[8];
  float* rs = (float*)(smem + 131072);
  row_rstd256((const u16*)(p.ws + O_CKV) + (size_t)rt * 256 * 256, 256, rs);
  gemm256<false>(acc, (const u16*)(p.ws + O_CKV) + (size_t)rt * 256 * 256, (const u16*)(p.ws + O_WUKV) + (size_t)ct * 256 * 256,
                 256, smem, ss);
    const int tid = rtid(), wid = __builtin_amdgcn_readfirstlane(tid >> 6), lane = tid & 63, wr = wid >> 2, wc = wid & 3, fr = lane & 15,
            fq = lane >> 4;

  const int bl = rt / 9, pos0 = (rt % 9) * 256;
  const int hk = ct * 2 + (wc >> 1);
  u16* Kb = (u16*)(p.ws + O_K) + ((size_t)bl * 8 + hk) * kS * 96;
  u16* Vb = (u16*)(p.ws + O_VT) + ((size_t)bl * 8 + hk) * 64 * kS;
  if ((wc & 1) == 0) {
#pragma unroll
    for (int m = 0; m < 8; ++m) {
      MEMFENCE();
      const float rstd = rs[wr * 128 + m * 16 + fr];
      const int pos = pos0 + wr * 128 + m * 16 + fr;
#pragma unroll
      for (int n = 0; n < 4; ++n) {
        const uint2 o = {pack2(acc[m][n][0] * rstd, acc[m][n][1] * rstd), pack2(acc[m][n][2] * rstd, acc[m][n][3] * rstd)};
        *(uint2*)(Kb + (size_t)pos * 96 + n * 16 + fq * 4) = o;
      }
    }
  } else {
    const int q0 = lane & 1, q1 = (lane >> 1) & 1;
#pragma unroll
    for (int m = 0; m < 8; ++m) {
      MEMFENCE();
      const float rstd = rs[wr * 128 + m * 16 + fr];
      const int pos4 = pos0 + wr * 128 + m * 16 + (fr & ~3);
#pragma unroll
      for (int n = 0; n < 4; ++n) {
        float v0 = acc[m][n][0] * rstd, v1 = acc[m][n][1] * rstd, v2 = acc[m][n][2] * rstd, v3 = acc[m][n][3] * rstd;
        {
          const float s01 = q0 ? v0 : v1, s23 = q0 ? v2 : v3;
          const float r01 = __int_as_float(__builtin_amdgcn_mov_dpp(__float_as_int(s01), 0xB1, 0xF, 0xF, true));
          const float r23 = __int_as_float(__builtin_amdgcn_mov_dpp(__float_as_int(s23), 0xB1, 0xF, 0xF, true));
          if (q0) { v0 = r01; v2 = r23; } else { v1 = r01; v3 = r23; }
        }
        {
          const float s02 = q1 ? v0 : v2, s13 = q1 ? v1 : v3;
          const float r02 = __int_as_float(__builtin_amdgcn_mov_dpp(__float_as_int(s02), 0x4E, 0xF, 0xF, true));
          const float r13 = __int_as_float(__builtin_amdgcn_mov_dpp(__float_as_int(s13), 0x4E, 0xF, 0xF, true));
          if (q1) { v0 = r02; v1 = r13; } else { v2 = r02; v3 = r13; }
        }
        const uint2 o = {pack2(v0, v1), pack2(v2, v3)};
        *(uint2*)(Vb + (size_t)(n * 16 + fq * 4 + (fr & 3)) * kS + pos4) = o;
      }
    }
  }
  if (ct == 0) {
    const float* SM = (const float*)(p.ws + O_SM);
    const float* rc = (const float*)(p.ws + O_ROPE);
    const float* rsn = rc + 2048 * 16;
    const int row = tid >> 1, axis = tid & 1;
    const int pos = pos0 + row;
    const float* kr = SM + ((size_t)bl * kS + pos) * 48 + axis * 16;
    float o[16];
#pragma unroll
    for (int f = 0; f < 8; ++f) {
      const float x1 = kr[f], x2 = kr[8 + f];
      if (pos < kT) {
        const float cs = rc[pos * 16 + axis * 8 + f], sn = rsn[pos * 16 + axis * 8 + f];
        o[f] = x1 * cs - x2 * sn;
        o[8 + f] = x1 * sn + x2 * cs;
      } else {
        o[f] = x1;
        o[8 + f] = x2;
      }
    }
    uint4 o0 = {pack2(o[0], o[1]), pack2(o[2], o[3]), pack2(o[4], o[5]), pack2(o[6], o[7])};
    uint4 o1 = {pack2(o[8], o[9]), pack2(o[10], o[11]), pack2(o[12], o[13]), pack2(o[14], o[15])};
#pragma unroll
    for (int hh = 0; hh < 8; ++hh) {
      u16* d = (u16*)(p.ws + O_K) + (((size_t)bl * 8 + hh) * kS + pos) * 96 + 64 + axis * 16;
      *(uint4*)d = o0;
      *(uint4*)(d + 8) = o1;
    }
  }
}
DI void phase3(const Params& p, char* smemh) {
  for (int w2 = blockIdx.x; w2 < kNITEM / 2; w2 += gridDim.x) dn_intra(p, 2 * w2 + hid(), smemh);
}

DI void st8(u16* d, uint4 v) {
  *(uint2*)d = make_uint2(v.x, v.y);
  *(uint2*)(d + 4) = make_uint2(v.z, v.w);
}
DI void dn_scan(const Params& p, int sb, char* smem) {
  const int tid = otid(), lane = tid & 63, wid = tid >> 6, r = lane & 31, h = lane >> 5;
  const int dir = sb & 1, hd = (sb >> 1) & 3, bl = sb >> 3;
  const int dvb = wid * 32;
  u16* sW = (u16*)smem;
  u16* sK = sW + 64 * 132;
  const float* EDL = (const float*)(p.ws + O_EDL);
  f32x16 S[4];
#pragma unroll
  for (int k = 0; k < 4; ++k)
#pragma unroll
    for (int i = 0; i < 16; ++i) S[k][i] = 0.f;
  uint4 pw[4], pk[4];
  uint2 pu[8];
  auto chunk_of = [&](int step) {
    return step < 4 ? (dir ? 35 - step : 32 + step) : (dir ? 31 - (step - 4) : (step - 4));
  };
  auto prefetch = [&](int step) {
    const int c = chunk_of(step);
    const int item = (((bl * 36 + c) * 4 + hd) << 1) | dir;
    const char* ib = p.ws + O_DN + (size_t)item * kDNITEM;
#pragma unroll
    for (int i = 0; i < 4; ++i) {
      pw[i] = *(const uint4*)(ib + 16384 + (size_t)(i * 256 + tid) * 16);
      pk[i] = *(const uint4*)(ib + 32768 + (size_t)(i * 256 + tid) * 16);
    }
    const u16* UdT = (const u16*)ib;
#pragma unroll
    for (int mb = 0; mb < 2; ++mb)
#pragma unroll
      for (int g = 0; g < 4; ++g) pu[mb * 4 + g] = *(const uint2*)(UdT + (dvb + r) * 64 + mb * 32 + 8 * g + 4 * h);
  };
  __syncthreads();
  prefetch(0);
  for (int step = 0; step < 36; ++step) {
    const int c = chunk_of(step);
    const bool lat = c < 32;
    const int item = (((bl * 36 + c) * 4 + hd) << 1) | dir;
#pragma unroll
    for (int i = 0; i < 4; ++i) {
      const int ch = i * 256 + tid;
      st8(sW + (ch >> 4) * 132 + (ch & 15) * 8, pw[i]);
      st8(sK + (ch >> 3) * 68 + (ch & 7) * 8, pk[i]);
    }
    f32x16 vn[2];
#pragma unroll
    for (int mb = 0; mb < 2; ++mb)
#pragma unroll
      for (int g = 0; g < 4; ++g) {
        const uint2 u = pu[mb * 4 + g];
        vn[mb][4 * g + 0] = bflo(u.x);
        vn[mb][4 * g + 1] = bfhi(u.x);
        vn[mb][4 * g + 2] = bflo(u.y);
        vn[mb][4 * g + 3] = bfhi(u.y);
      }
    const float edl = EDL[item];
    __syncthreads();
    if (step + 1 < 36) prefetch(step + 1);
    const int sidx = (((bl * 32 + (c & 31)) * 4 + hd) << 1) | dir;
    u16* STf = (u16*)((char*)p.out + 67108864) + (size_t)sidx * 16384 + wid * 4096 + lane * 8;
#pragma unroll
    for (int kb = 0; kb < 4; ++kb)
#pragma unroll
      for (int s = 0; s < 2; ++s) {
        const bf16x8 bS = pack8(S[kb], s);
        if (lat) *(bf16x8*)(STf + (kb * 2 + s) * 512) = bS;
        const int ko = kb * 32 + s * 16 + 4 * h;
#pragma unroll
        for (int mb = 0; mb < 2; ++mb) {
          const u16* wp = sW + (mb * 32 + r) * 132 + ko;
          vn[mb] = MFMA32(cat8(*(const uint2*)wp, *(const uint2*)(wp + 8)), bS, vn[mb]);
        }
      }
    u16* Vf = (u16*)(p.ws + O_DN + (size_t)item * kDNITEM) + wid * 2048 + lane * 8;
#pragma unroll
    for (int k = 0; k < 4; ++k)
#pragma unroll
      for (int i = 0; i < 16; ++i) S[k][i] *= edl;
#pragma unroll
    for (int kb2 = 0; kb2 < 2; ++kb2)
#pragma unroll
      for (int s = 0; s < 2; ++s) {
        const bf16x8 bV = pack8(vn[kb2], s);
        if (lat) *(bf16x8*)(Vf + (kb2 * 2 + s) * 512) = bV;
        const int ko = kb2 * 32 + s * 16 + 4 * h;
#pragma unroll
        for (int dkb = 0; dkb < 4; ++dkb) {
          const u16* kp = sK + (dkb * 32 + r) * 68 + ko;
          S[dkb] = MFMA32(cat8(*(const uint2*)kp, *(const uint2*)(kp + 8)), bV, S[dkb]);
        }
      }
    __syncthreads();
  }
}

DI void attn_item(const Params& p, int w, char* smem) {
  const int tid = otid(), lane = tid & 63, wid = tid >> 6, r = lane & 31, h = lane >> 5;
  const int qb = w & 15, hh = (w >> 4) & 7, bl = w >> 7;
  const u16* Qp = (const u16*)(p.ws + O_Q) + (((size_t)bl * 8 + hh) * kT + qb * 128) * 96;
  const u16* Kp = (const u16*)(p.ws + O_K) + ((size_t)bl * 8 + hh) * kS * 96;
  const u16* Vp = (const u16*)(p.ws + O_VT) + ((size_t)bl * 8 + hh) * 64 * kS;
  u16* sKb = (u16*)smem;
  u16* sVb = sKb + 2 * 64 * 104;
  bf16x8 qf[6];
#pragma unroll
  for (int ks = 0; ks < 6; ++ks) qf[ks] = *(const bf16x8*)(Qp + (size_t)(wid * 32 + r) * 96 + ks * 16 + h * 8);
  f32x16 o[2];
#pragma unroll
  for (int d = 0; d < 2; ++d)
#pragma unroll
    for (int i = 0; i < 16; ++i) o[d][i] = 0.f;
  float m = -INFINITY, l = 0.f;
  uint4 rk0, rk1, rk2, rv0, rv1;
#define ATT_GLOAD(kt)                                                                              \
  do {                                                                                             \
    const u16* kp_ = Kp + (size_t)(kt) * 64 * 96 + (size_t)tid * 8;                                \
    rk0 = *(const uint4*)(kp_);                                                                    \
    rk1 = *(const uint4*)(kp_ + 2048);                                                             \
    rk2 = *(const uint4*)(kp_ + 4096);                                                             \
    rv0 = *(const uint4*)(Vp + (size_t)(tid >> 3) * kS + (kt) * 64 + (tid & 7) * 8);               \
    rv1 = *(const uint4*)(Vp + (size_t)((tid + 256) >> 3) * kS + (kt) * 64 + (tid & 7) * 8);       \
  } while (0)
#define ATT_LSTORE(buf)                                                                            \
  do {                                                                                             \
    u16* kb_ = sKb + (buf) * 64 * 104;                                                             \
    *(uint4*)(kb_ + (tid / 12) * 104 + (tid % 12) * 8) = rk0;                                      \
    *(uint4*)(kb_ + ((tid + 256) / 12) * 104 + ((tid + 256) % 12) * 8) = rk1;                      \
    *(uint4*)(kb_ + ((tid + 512) / 12) * 104 + ((tid + 512) % 12) * 8) = rk2;                      \
    u16* vb_ = sVb + (buf) * 64 * 68;                                                              \
    st8(vb_ + (tid >> 3) * 68 + (tid & 7) * 8, rv0);                                               \
    st8(vb_ + ((tid + 256) >> 3) * 68 + (tid & 7) * 8, rv1);                                       \
  } while (0)
  __syncthreads();
  ATT_GLOAD(0);
  ATT_LSTORE(0);
  __syncthreads();
  for (int kt = 0; kt < 36; ++kt) {
    const int buf = kt & 1;
    if (kt + 1 < 36) ATT_GLOAD(kt + 1);
    const u16* sK = sKb + buf * 64 * 104;
    const u16* sV = sVb + buf * 64 * 68;
    f32x16 st[2];
#pragma unroll
    for (int kb = 0; kb < 2; ++kb) {
#pragma unroll
      for (int i = 0; i < 16; ++i) st[kb][i] = 0.f;
#pragma unroll
      for (int ks = 0; ks < 6; ++ks) {
        const bf16x8 a = *(const bf16x8*)(sK + (kb * 32 + r) * 104 + ks * 16 + h * 8);
        st[kb] = MFMA32(a, qf[ks], st[kb]);
      }
    }
    float mx = st[0][0];
#pragma unroll
    for (int kb = 0; kb < 2; ++kb)
#pragma unroll
      for (int i = 0; i < 16; ++i) mx = fmaxf(mx, st[kb][i]);
    mx = fmaxf(mx, shx(mx, 32, lane));
    const float mn = fmaxf(m, mx);
    const float alpha = __builtin_amdgcn_exp2f(m - mn);
    float rsum = 0.f;
#pragma unroll
    for (int kb = 0; kb < 2; ++kb)
#pragma unroll
      for (int i = 0; i < 16; ++i) {
        const float pe = __builtin_amdgcn_exp2f(st[kb][i] - mn);
        st[kb][i] = pe;
        rsum += pe;
      }
    rsum += shx(rsum, 32, lane);
    l = l * alpha + rsum;
    m = mn;
#pragma unroll
    for (int d = 0; d < 2; ++d)
#pragma unroll
      for (int i = 0; i < 16; ++i) o[d][i] *= alpha;
#pragma unroll
    for (int kb = 0; kb < 2; ++kb)
#pragma unroll
      for (int s = 0; s < 2; ++s) {
        const bf16x8 bP = pack8(st[kb], s);
        const int ko = kb * 32 + s * 16 + 4 * h;
#pragma unroll
        for (int d = 0; d < 2; ++d) {
          const u16* vp = sV + (d * 32 + r) * 68 + ko;
          o[d] = MFMA32(cat8(*(const uint2*)vp, *(const uint2*)(vp + 8)), bP, o[d]);
        }
      }
    if (kt + 1 < 36) ATT_LSTORE(buf ^ 1);
    __syncthreads();
  }
  const float inv = 1.f / l;
  u16* Od = (u16*)(p.ws + O_OMLA) + ((size_t)bl * kT + qb * 128 + wid * 32 + r) * 512 + hh * 64;
#pragma unroll
  for (int d = 0; d < 2; ++d)
#pragma unroll
    for (int g = 0; g < 4; ++g) {
      uint2 ov = {pack2(o[d][4 * g] * inv, o[d][4 * g + 1] * inv), pack2(o[d][4 * g + 2] * inv, o[d][4 * g + 3] * inv)};
      *(uint2*)(Od + d * 32 + 8 * g + 4 * h) = ov;
    }
}
DI void attn_pair(const Params& p, int head, int qp, char* smem) {
  const int tid = rtid(), lane = tid & 63, wid = tid >> 6, r = lane & 31, h = lane >> 5;
  const int bl = head >> 3, hh = head & 7;
  const u16* Qp = (const u16*)(p.ws + O_Q) + (((size_t)bl * 8 + hh) * kT + qp * 256) * 96;
  const u16* Kp = (const u16*)(p.ws + O_K) + ((size_t)bl * 8 + hh) * kS * 96;
  const u16* Vp = (const u16*)(p.ws + O_VT) + ((size_t)bl * 8 + hh) * 64 * kS;
  u16* sKb = (u16*)smem;
  u16* sVb = sKb + 2 * 128 * 104;
  bf16x8 qf[6];
#pragma unroll
  for (int ks = 0; ks < 6; ++ks) qf[ks] = *(const bf16x8*)(Qp + (size_t)(wid * 32 + r) * 96 + ks * 16 + h * 8);
  f32x16 o[2];
#pragma unroll
  for (int d = 0; d < 2; ++d)
#pragma unroll
    for (int i = 0; i < 16; ++i) o[d][i] = 0.f;
  float m = -INFINITY, l = 0.f;
  uint4 rk0, rk1, rk2, rv0, rv1;
#define AP_GLOAD(kt)                                                                               \
  do {                                                                                             \
    const u16* kp_ = Kp + (size_t)(kt) * 128 * 96 + (size_t)tid * 8;                               \
    rk0 = *(const uint4*)(kp_);                                                                    \
    rk1 = *(const uint4*)(kp_ + 4096);                                                             \
    rk2 = *(const uint4*)(kp_ + 8192);                                                             \
    rv0 = *(const uint4*)(Vp + (size_t)(tid >> 4) * kS + (kt) * 128 + (tid & 15) * 8);             \
    rv1 = *(const uint4*)(Vp + (size_t)((tid + 512) >> 4) * kS + (kt) * 128 + (tid & 15) * 8);     \
  } while (0)
#define AP_LSTORE(buf)                                                                             \
  do {                                                                                             \
    u16* kb_ = sKb + (buf) * 128 * 104;                                                            \
    *(uint4*)(kb_ + (tid / 12) * 104 + (tid % 12) * 8) = rk0;                                      \
    *(uint4*)(kb_ + ((tid + 512) / 12) * 104 + ((tid + 512) % 12) * 8) = rk1;                      \
    *(uint4*)(kb_ + ((tid + 1024) / 12) * 104 + ((tid + 1024) % 12) * 8) = rk2;                    \
    u16* vb_ = sVb + (buf) * 64 * 132;                                                             \
    st8(vb_ + (tid >> 4) * 132 + (tid & 15) * 8, rv0);                                             \
    st8(vb_ + ((tid + 512) >> 4) * 132 + (tid & 15) * 8, rv1);                                     \
  } while (0)
  __syncthreads();
  AP_GLOAD(0);
  AP_LSTORE(0);
  AP_GLOAD(1);
  __syncthreads();
  for (int kt = 0; kt < 18; ++kt) {
    const int buf = kt & 1;
    if (kt + 1 < 18) AP_LSTORE(buf ^ 1);
    if (kt + 2 < 18) AP_GLOAD(kt + 2);
    const u16* sK = sKb + buf * 128 * 104;
    const u16* sV = sVb + buf * 64 * 132;
    f32x16 st[4];
#pragma unroll
    for (int kb = 0; kb < 4; ++kb) {
#pragma unroll
      for (int i = 0; i < 16; ++i) st[kb][i] = 0.f;
#pragma unroll
      for (int ks = 0; ks < 6; ++ks) {
        const bf16x8 a = *(const bf16x8*)(sK + (kb * 32 + r) * 104 + ks * 16 + h * 8);
        st[kb] = MFMA32(a, qf[ks], st[kb]);
      }
    }
    float mx = st[0][0];
#pragma unroll
    for (int kb = 0; kb < 4; ++kb)
#pragma unroll
      for (int i = 0; i < 16; ++i) mx = fmaxf(mx, st[kb][i]);
    mx = fmaxf(mx, shx(mx, 32, lane));
    const float mn = fmaxf(m, mx);
    const float alpha = __builtin_amdgcn_exp2f(m - mn);
    float rsum = 0.f;
#pragma unroll
    for (int kb = 0; kb < 4; ++kb)
#pragma unroll
      for (int i = 0; i < 16; ++i) {
        const float pe = __builtin_amdgcn_exp2f(st[kb][i] - mn);
        st[kb][i] = pe;
        rsum += pe;
      }
    rsum += shx(rsum, 32, lane);
    l = l * alpha + rsum;
    m = mn;
#pragma unroll
    for (int d = 0; d < 2; ++d)
#pragma unroll
      for (int i = 0; i < 16; ++i) o[d][i] *= alpha;
#pragma unroll
    for (int kb = 0; kb < 4; ++kb)
#pragma unroll
      for (int s = 0; s < 2; ++s) {
        const bf16x8 bP = pack8(st[kb], s);
        const int ko = kb * 32 + s * 16 + 4 * h;
#pragma unroll
        for (int d = 0; d < 2; ++d) {
          const u16* vp = sV + (d * 32 + r) * 132 + ko;
          o[d] = MFMA32(cat8(*(const uint2*)vp, *(const uint2*)(vp + 8)), bP, o[d]);
        }
      }
    __syncthreads();
  }
#undef AP_GLOAD
#undef AP_LSTORE
  const float inv = 1.f / l;
  u16* Od = (u16*)(p.ws + O_OMLA) + ((size_t)bl * kT + qp * 256 + wid * 32 + r) * 512 + hh * 64;
#pragma unroll
  for (int d = 0; d < 2; ++d)
#pragma unroll
    for (int g = 0; g < 4; ++g) {
      uint2 ov = {pack2(o[d][4 * g] * inv, o[d][4 * g + 1] * inv), pack2(o[d][4 * g + 2] * inv, o[d][4 * g + 3] * inv)};
      *(uint2*)(Od + d * 32 + 8 * g + 4 * h) = ov;
    }
}
DI void phase3b(const Params& p, char* smem, char* smemh) {
  const int per_x = gridDim.x >> 3, xcd = blockIdx.x & 7, rank = blockIdx.x >> 3;
  if (per_x == 32) {
    if (rank >= 28) { dn_scan(p, (xcd * 4 + (rank - 28)) * 2 + hid(), smemh); return; }
    for (int w = blockIdx.x; w < 192 + 288; w += 224) {
      if (w < 192) qproj_tile(p, w / 3, w % 3, smem);
      else kvproj_tile(p, (w - 192) >> 2, (w - 192) & 3, smem);
    }
  } else {
    for (int w2 = blockIdx.x; w2 < 32; w2 += gridDim.x) dn_scan(p, 2 * w2 + hid(), smemh);
    FOR_TILES(64, 3, rt, ct) { qproj_tile(p, rt, ct, smem); }
    FOR_TILES(72, 4, rt, ct) { kvproj_tile(p, rt, ct, smem); }
  }
}
DI void phase5(const Params& p, char* smem);
DI void phase4(const Params& p, char* smemh) {
  const int per_x = gridDim.x >> 3, xcd = blockIdx.x & 7, rank = blockIdx.x >> 3;
  if (per_x == 32) {
    char* smem0 = smemh - hid() * 73728;
    if (rank & 1) phase5(p, smemh);
    for (int it = 0; it < 2; ++it) attn_pair(p, it * 32 + xcd * 4 + (rank >> 3), rank & 7, smem0);
    if (!(rank & 1)) phase5(p, smemh);
  } else {
    for (int w2 = blockIdx.x; w2 < 512; w2 += gridDim.x) attn_item(p, 2 * w2 + hid(), smemh);
    phase5(p, smemh);
  }
}

DI void phase5(const Params& p, char* smem) {
  const int tid = otid(), lane = tid & 63, wid = tid >> 6, r = lane & 31, h = lane >> 5;
  const int dvb = wid * 32;
  float* red = (float*)smem;
  const u16* Z = (const u16*)(p.ws + O_Z);
  u16* ODN = (u16*)(p.ws + O_ODN);
  for (int w2 = blockIdx.x; w2 < kNB * 32 * 2; w2 += gridDim.x) {
    const int w = 2 * w2 + hid();
    const int hd = w & 3, c = (w >> 2) & 31, bl = w >> 7;
    f32x16 o[2][2];
#pragma unroll
    for (int dir = 0; dir < 2; ++dir) {
      const int item = (((bl * 36 + c) * 4 + hd) << 1) | dir;
      const int sidx = (((bl * 32 + c) * 4 + hd) << 1) | dir;
      const char* ib = p.ws + O_DN + (size_t)item * kDNITEM;
      const u16* VnT = (const u16*)ib;
      const u16* Qg = (const u16*)(ib + 49152);
      const u16* QKd = (const u16*)(ib + 65536);
      const u16* ST = (const u16*)((const char*)p.out + 67108864) + (size_t)sidx * 16384;
#pragma unroll
      for (int mb = 0; mb < 2; ++mb)
#pragma unroll
        for (int i = 0; i < 16; ++i) o[dir][mb][i] = 0.f;
      const u16* STf = ST + wid * 4096 + lane * 8;
      const u16* Vf = VnT + wid * 2048 + lane * 8;
#pragma unroll
      for (int kb = 0; kb < 4; ++kb)
#pragma unroll
        for (int s = 0; s < 2; ++s) {
          const bf16x8 bS = *(const bf16x8*)(STf + (kb * 2 + s) * 512);
          const int ko = kb * 32 + s * 16 + 4 * h;
#pragma unroll
          for (int mb = 0; mb < 2; ++mb) {
            const u16* qp = Qg + (mb * 32 + r) * 128 + ko;
            o[dir][mb] = MFMA32(cat8(*(const uint2*)qp, *(const uint2*)(qp + 8)), bS, o[dir][mb]);
          }
        }
#pragma unroll
      for (int kb2 = 0; kb2 < 2; ++kb2)
#pragma unroll
        for (int s = 0; s < 2; ++s) {
          const bf16x8 bV = *(const bf16x8*)(Vf + (kb2 * 2 + s) * 512);
          const int ko = kb2 * 32 + s * 16 + 4 * h;
#pragma unroll
          for (int mb = 0; mb < 2; ++mb) {
            const u16* qp = QKd + (mb * 32 + r) * 64 + ko;
            o[dir][mb] = MFMA32(cat8(*(const uint2*)qp, *(const uint2*)(qp + 8)), bV, o[dir][mb]);
          }
        }
    }
    float os[2][16];
#pragma unroll
    for (int mb = 0; mb < 2; ++mb)
#pragma unroll
      for (int i = 0; i < 16; ++i) {
        const int ip = (3 - (i & 3)) + 4 * (3 - (i >> 2));
        os[mb][i] = o[0][mb][i] + shx(o[1][1 - mb][ip], 32, lane);
      }
    __syncthreads();
#pragma unroll
    for (int mb = 0; mb < 2; ++mb)
#pragma unroll
      for (int i = 0; i < 16; ++i) {
        float s = os[mb][i] * os[mb][i];
        s += shx(s, 1, lane);
        s += shx(s, 2, lane);
        s += shx(s, 4, lane);
        s += shx(s, 8, lane);
        s += shx(s, 16, lane);
        if (r == 0) red[wid * 64 + mb * 32 + crow(i, h)] = s;
      }
    __syncthreads();
#pragma unroll
    for (int mb = 0; mb < 2; ++mb)
#pragma unroll
      for (int i = 0; i < 16; ++i) {
        const int tok = mb * 32 + crow(i, h);
        const float ss = red[tok] + red[64 + tok] + red[128 + tok] + red[192 + tok];
        const float rstd = rsqrtf(ss * (1.f / 128.f) + kEPS);
        const size_t off = ((size_t)bl * kT + c * 64 + tok) * 512 + hd * 128 + dvb + r;
        ODN[off] = f2bf(os[mb][i] * rstd * siluf_(bf2f(Z[off])));
      }
  }
}

DI void phase6(const Params& p, int pass, char* smem) {
  const u16* GA = (const u16*)(p.ws + O_GA);
  const u16* GB = (const u16*)(p.ws + O_GB);
  u16* M = (u16*)p.out + (size_t)pass * kRL * 1024;
  FOR_TILES(64, 4, rt, ct) {
    f32x4 acc[8][4];
    zero_acc(acc);
    float ss[8];
    gemm256<false>(acc, (const u16*)(p.ws + O_OMLA) + (size_t)rt * 256 * 512, (const u16*)(p.ws + O_WOMLA) + (size_t)ct * 256 * 512,
                   512, smem, ss);
    const int tid = rtid(), wid = tid >> 6, lane = tid & 63, wr = wid >> 2, wc = wid & 3, fr = lane & 15, fq = lane >> 4;
    const int row0 = rt * 256 + wr * 128 + fr, col0 = ct * 256 + wc * 64 + fq * 4;
    FOR_FRAG(m, n) {
      MEMFENCE();
      const size_t off = (size_t)(row0 + m * 16) * 1024 + col0 + n * 16;
      const uint2 ga = *(const uint2*)(GA + off);
      const uint2 o = {pack2(acc[m][n][0] * sigmoidf_(bflo(ga.x)), acc[m][n][1] * sigmoidf_(bfhi(ga.x))),
                       pack2(acc[m][n][2] * sigmoidf_(bflo(ga.y)), acc[m][n][3] * sigmoidf_(bfhi(ga.y)))};
      *(uint2*)(M + off) = o;
    }
  }
  FOR_TILES(64, 4, rt, ct) {
    f32x4 acc[8][4];
    zero_acc(acc);
    float ss[8];
    gemm256<false>(acc, (const u16*)(p.ws + O_ODN) + (size_t)rt * 256 * 512, (const u16*)(p.ws + O_WODN) + (size_t)ct * 256 * 512,
                   512, smem, ss);
    const int tid = rtid(), wid = tid >> 6, lane = tid & 63, wr = wid >> 2, wc = wid & 3, fr = lane & 15, fq = lane >> 4;
    const int row0 = rt * 256 + wr * 128 + fr, col0 = ct * 256 + wc * 64 + fq * 4;
    FOR_FRAG(m, n) {
      MEMFENCE();
      const size_t off = (size_t)(row0 + m * 16) * 1024 + col0 + n * 16;
      const uint2 gb = *(const uint2*)(GB + off);
      const uint2 ya = *(const uint2*)(M + off);
      const uint2 o = {pack2(bflo(ya.x) + acc[m][n][0] * sigmoidf_(bflo(gb.x)), bfhi(ya.x) + acc[m][n][1] * sigmoidf_(bfhi(gb.x))),
                       pack2(bflo(ya.y) + acc[m][n][2] * sigmoidf_(bflo(gb.y)), bfhi(ya.y) + acc[m][n][3] * sigmoidf_(bfhi(gb.y)))};
      stnt_u2(M + off, o);
    }
  }
}

template <int K>
DI void gemm_plain(const u16* A, const u16* Bt, u16* C, int ldc, int mt, int nt, char* smem) {
  FOR_TILES(mt, nt, rt, ct) {
    f32x4 acc[8][4];
    zero_acc(acc);
    float ss[8];
    gemm256<false>(acc, A + (size_t)rt * 256 * K, Bt + (size_t)ct * 256 * K, K, smem, ss);
    const int tid = rtid(), wid = tid >> 6, lane = tid & 63, wr = wid >> 2, wc = wid & 3, fr = lane & 15, fq = lane >> 4;

    const int row0 = rt * 256 + wr * 128 + fr, col0 = ct * 256 + wc * 64 + fq * 4;
    FOR_FRAG(m, n) {
      const uint2 o = {pack2(acc[m][n][0], acc[m][n][1]), pack2(acc[m][n][2], acc[m][n][3])};
      *(uint2*)(C + (size_t)(row0 + m * 16) * ldc + col0 + n * 16) = o;
    }
  }
}
DI void phase_ffn_in(const Params& p, char* smem) {
  const u16* A = (const u16*)(p.ws + O_U2);
  const u16* Bt = (const u16*)(p.ws + O_WFFI);
  u16* H = (u16*)(p.ws + O_H);
  const int nranks = gridDim.x >> 3;
  FOR_TILES_N(128, 22, nranks, ((nranks & 1) == 0 ? 2 : 1), rt, ct) {
    f32x4 acc[8][4];
    zero_acc(acc);
    float ss[8];
    gemm256<false>(acc, A + (size_t)rt * 256 * 1024, Bt + (size_t)ct * 256 * 1024, 1024, smem, ss);
    const int tid = rtid(), wid = tid >> 6, lane = tid & 63, wr = wid >> 2, wc = wid & 3, fr = lane & 15, fq = lane >> 4;

    const int row0 = rt * 256 + wr * 128 + fr, hc0 = ct * 128 + wc * 32 + fq * 4;
#pragma unroll
    for (int m = 0; m < 8; ++m)
#pragma unroll
      for (int n2 = 0; n2 < 2; ++n2) {
        const f32x4 g = acc[m][2 * n2], u = acc[m][2 * n2 + 1];
        const uint2 o = {pack2(siluf_(g[0]) * u[0], siluf_(g[1]) * u[1]), pack2(siluf_(g[2]) * u[2], siluf_(g[3]) * u[3])};
        *(uint2*)(H + (size_t)(row0 + m * 16) * kFF + hc0 + n2 * 16) = o;
      }
  }
}

DI void phase_post_mix(const Params& p) {
  const int tid_ = rtid(); const int lane = tid_ & 63, wv = tid_ >> 6;
  const float* mod = (const float*)(p.ws + O_MOD);
  const u16* Y = (const u16*)(p.ws + O_Y);
  u16* U2 = (u16*)(p.ws + O_U2);
  for (int row = blockIdx.x * 8 + wv; row < 32768; row += gridDim.x * 8) {
    const int b = row >> 11;
    const float* md = mod + b * 6144;
    float y[16];
    float ssy = 0.f;
#pragma unroll
    for (int i = 0; i < 4; ++i) {
      const uint2 u = ldnt_u2(Y + (size_t)row * 1024 + i * 256 + lane * 4);
      y[4 * i] = bflo(u.x); y[4 * i + 1] = bfhi(u.x); y[4 * i + 2] = bflo(u.y); y[4 * i + 3] = bfhi(u.y);
#pragma unroll
      for (int e = 0; e < 4; ++e) ssy += y[4 * i + e] * y[4 * i + e];
    }
    ssy = wave_sum(ssy, lane);
    const float rsy = rsqrtf(ssy * (1.f / 1024.f) + kEPS);
    float x1[16];
    float ss1 = 0.f;
#pragma unroll
    for (int i = 0; i < 4; ++i) {
      const int k = i * 256 + lane * 4;
      const float4 xv = ldnt_f4(p.x + (size_t)row * 1024 + k);
      const float4 g = *(const float4*)(p.g_post_mix + k), gt = *(const float4*)(md + 2048 + k);
      x1[4 * i + 0] = xv.x + gt.x * (y[4 * i + 0] * rsy * g.x);
      x1[4 * i + 1] = xv.y + gt.y * (y[4 * i + 1] * rsy * g.y);
      x1[4 * i + 2] = xv.z + gt.z * (y[4 * i + 2] * rsy * g.z);
      x1[4 * i + 3] = xv.w + gt.w * (y[4 * i + 3] * rsy * g.w);
      stnt_f4(p.out + (size_t)row * 1024 + k, make_float4(x1[4 * i], x1[4 * i + 1], x1[4 * i + 2], x1[4 * i + 3]));
#pragma unroll
      for (int e = 0; e < 4; ++e) ss1 += x1[4 * i + e] * x1[4 * i + e];
    }
    ss1 = wave_sum(ss1, lane);
    const float rs1 = rsqrtf(ss1 * (1.f / 1024.f) + kEPS);
#pragma unroll
    for (int i = 0; i < 4; ++i) {
      const int k = i * 256 + lane * 4;
      const float4 g = *(const float4*)(p.g_pre_ffn + k), sh = *(const float4*)(md + 3072 + k), sc = *(const float4*)(md + 4096 + k);
      uint2 o;
      o.x = pack2(x1[4 * i + 0] * rs1 * g.x * (1.f + sc.x) + sh.x, x1[4 * i + 1] * rs1 * g.y * (1.f + sc.y) + sh.y);
      o.y = pack2(x1[4 * i + 2] * rs1 * g.z * (1.f + sc.z) + sh.z, x1[4 * i + 3] * rs1 * g.w * (1.f + sc.w) + sh.w);
      *(uint2*)(U2 + (size_t)row * 1024 + k) = o;
    }
  }
}
DI void phase_final(const Params& p) {
  const int tid_ = rtid(); const int lane = tid_ & 63, wv = tid_ >> 6;
  const float* mod = (const float*)(p.ws + O_MOD);
  const u16* F = (const u16*)(p.ws + O_Y);
  for (int row = blockIdx.x * 8 + wv; row < 32768; row += gridDim.x * 8) {
    const int b = row >> 11;
    const float* md = mod + b * 6144;
    float y[16];
    float ssy = 0.f;
#pragma unroll
    for (int i = 0; i < 4; ++i) {
      const uint2 u = ldnt_u2(F + (size_t)row * 1024 + i * 256 + lane * 4);
      y[4 * i] = bflo(u.x); y[4 * i + 1] = bfhi(u.x); y[4 * i + 2] = bflo(u.y); y[4 * i + 3] = bfhi(u.y);
#pragma unroll
      for (int e = 0; e < 4; ++e) ssy += y[4 * i + e] * y[4 * i + e];
    }
    ssy = wave_sum(ssy, lane);
    const float rsy = rsqrtf(ssy * (1.f / 1024.f) + kEPS);
#pragma unroll
    for (int i = 0; i < 4; ++i) {
      const int k = i * 256 + lane * 4;
      float4 xv = ldnt_f4(p.out + (size_t)row * 1024 + k);
      const float4 g = *(const float4*)(p.g_post_ffn + k), gt = *(const float4*)(md + 5120 + k);
      xv.x += gt.x * (y[4 * i + 0] * rsy * g.x);
      xv.y += gt.y * (y[4 * i + 1] * rsy * g.y);
      xv.z += gt.z * (y[4 * i + 2] * rsy * g.z);
      xv.w += gt.w * (y[4 * i + 3] * rsy * g.w);
      stnt_f4(p.out + (size_t)row * 1024 + k, xv);
    }
  }
}

constexpr int kNPH = 18;
__global__ void __launch_bounds__(512, 2) fwd_kernel(Params pin) {
  __shared__ __attribute__((aligned(1024))) char smem[147456];
  char* smemh = smem + hid() * 73728;
  __shared__ uint4 xb_words;
  if (__builtin_amdgcn_workitem_id_x() == 0) xb_words = make_uint4(0u, 0u, 0u, 0u);
  __syncthreads();
  XcdBarrier xb = xcd_barrier_post((unsigned*)(pin.ws + O_BAR), (volatile LAS unsigned*)&xb_words);
  if (pin.ph_lo > 1000) cg::this_grid().sync();
#define WS_OPAQUE()                                                                          \
  Params p = pin;                                                                            \
  {                                                                                          \
    typedef __attribute__((address_space(1))) char gchar_t;                                  \
    gchar_t* g_ = (gchar_t*)pin.ws;                                                          \
    asm volatile("" : "+s"(g_));                                                             \
    p.ws = (char*)g_;                                                                        \
  }
#define PHASE(k, call)                                                                       \
  if (pin.ph_lo <= (k) && (k) < pin.ph_hi) {                                                 \
    { WS_OPAQUE(); call; }                                                                   \
    if ((k) + 1 < pin.ph_hi) xcd_barrier(xb);                                                \
  }
  PHASE(0, phase0(p, smemh))
  PHASE(1, phase1(p, 0))
  PHASE(2, phase2(p, smem))
  PHASE(3, phase3(p, smemh))
  PHASE(4, phase3b(p, smem, smemh))
  PHASE(5, phase4(p, smemh))
  PHASE(6, phase6(p, 0, smem))
  PHASE(7, phase1(p, 1))
  PHASE(8, phase2(p, smem))
  PHASE(9, phase3(p, smemh))
  PHASE(10, phase3b(p, smem, smemh))
  PHASE(11, phase4(p, smemh))
  PHASE(12, phase6(p, 1, smem))
  PHASE(13, gemm_plain<1024>((const u16*)p.out, (const u16*)(p.ws + O_WOUT), (u16*)(p.ws + O_Y), 1024, 128, 4, smem))
  PHASE(14, phase_post_mix(p))
  PHASE(15, phase_ffn_in(p, smem))
  PHASE(16, gemm_plain<kFF>((const u16*)(p.ws + O_H), (const u16*)(p.ws + O_WFFO), (u16*)(p.ws + O_Y), 1024, 128, 4, smem))
  PHASE(17, phase_final(p))
#undef PHASE
#undef WS_OPAQUE
}

extern "C" void kernel_launch(void* const* d_in, const int* in_sizes, int n_in, void* d_out, int out_size, void* d_ws,
                              size_t ws_size, hipStream_t stream) {
  Params p{};
  const float** f = (const float**)&p;
  for (int i = 0; i < 24; ++i) f[i] = (const float*)d_in[i];
  p.out = (float*)d_out;
  p.ws = (char*)d_ws;
#if COOP
  static int grid_blocks = 0;
  if (!grid_blocks) {
    int dev = 0, cus = 0, per_cu = 0;
    hipGetDevice(&dev);
    hipDeviceGetAttribute(&cus, hipDeviceAttributeMultiprocessorCount, dev);
    hipOccupancyMaxActiveBlocksPerMultiprocessor(&per_cu, fwd_kernel, 512, 0);
    if (per_cu > 1) per_cu = 1;
    grid_blocks = cus * per_cu;
  }
  p.ph_lo = 0;
  p.ph_hi = kNPH;
  hipMemsetAsync((char*)d_ws + O_BAR, 0, 16384, stream);
  void* args[] = {&p};
  hipError_t e = hipLaunchCooperativeKernel((void*)fwd_kernel, dim3(grid_blocks), dim3(512), args, 0, stream);
  if (e != hipSuccess) fprintf(stderr, "cooperative launch failed: %s (grid %d)\n", hipGetErrorString(e), grid_blocks);
#else
  for (int ph = 0; ph < kNPH; ++ph) {
    p.ph_lo = ph;
    p.ph_hi = ph + 1;
    fwd_kernel<<<dim3(256), dim3(512), 0, stream>>>(p);
  }
#endif
}
```

```cpp
#include <hip/hip_runtime.h>
#include <hip/hip_cooperative_groups.h>
#include <cstdio>
namespace cg = cooperative_groups;

typedef unsigned short u16;
using bf16x8 = __attribute__((ext_vector_type(8))) short;
using f32x16 = __attribute__((ext_vector_type(16))) float;
typedef __bf16 bf2_t __attribute__((ext_vector_type(2)));
typedef float f2_t __attribute__((ext_vector_type(2)));
#define DI __device__ __forceinline__
#define MFMA32(a, b, c) __builtin_amdgcn_mfma_f32_32x32x16_bf16((a), (b), (c), 0, 0, 0)

#ifndef PHMASK
#define PHMASK 0xfff
#endif
#ifndef P4SEL
#define P4SEL 3
#endif
#ifndef COOP
#define COOP 1
#endif

constexpr int kD = 1024, kT = 2048, kS = 2304, kNB = 8, kNPASS = 2;
constexpr int kR = kNB * kS;
constexpr int kRL = kNB * kT;
constexpr int kFF = 2816, kINP = 5120;
constexpr int kNITEM = kNB * 36 * 4 * 2;
constexpr float kEPS = 1e-6f;
constexpr float kQSCALE = 0.10206207261596575f * 1.4426950408889634f;
constexpr float kDKS = 0.08838834764831845f;

constexpr size_t al256(size_t x) { return (x + 255) & ~(size_t)255; }
constexpr size_t O_WIN = 0;
constexpr size_t O_WUQ = O_WIN + al256((size_t)kINP * 1024 * 2);
constexpr size_t O_WUKV = O_WUQ + al256((size_t)768 * 512 * 2);
constexpr size_t O_WOMLA = O_WUKV + al256((size_t)1024 * 256 * 2);
constexpr size_t O_WODN = O_WOMLA + al256((size_t)1024 * 512 * 2);
constexpr size_t O_WOUT = O_WODN + al256((size_t)1024 * 512 * 2);
constexpr size_t O_WFFI = O_WOUT + al256((size_t)1024 * 1024 * 2);
constexpr size_t O_WFFO = O_WFFI + al256((size_t)5632 * 1024 * 2);
constexpr size_t O_MOD = O_WFFO + al256((size_t)1024 * 2816 * 2);
constexpr size_t O_ROPE = O_MOD + al256((size_t)17 * 6144 * 4);
constexpr size_t O_PASS = O_ROPE + al256((size_t)2048 * 32 * 4);
constexpr size_t O_U = O_PASS;
constexpr size_t O_CQ = O_U + al256((size_t)kR * 1024 * 2);
constexpr size_t O_CKV = O_CQ + al256((size_t)kRL * 512 * 2);
constexpr size_t O_SM = O_CKV + al256((size_t)kR * 256 * 2);
constexpr size_t O_QKV = O_SM + al256((size_t)kR * 48 * 4);
constexpr size_t O_Z = O_QKV + al256((size_t)kR * 1536 * 2);
constexpr size_t O_GA = O_Z + al256((size_t)kRL * 512 * 2);
constexpr size_t O_GB = O_GA + al256((size_t)kRL * 1024 * 2);
constexpr size_t O_Q = O_GB + al256((size_t)kRL * 1024 * 2);
constexpr size_t O_K = O_Q + al256((size_t)kRL * 768 * 2);
constexpr size_t O_VT = O_K + al256((size_t)kR * 768 * 2);
constexpr size_t O_DN = O_VT + al256((size_t)kR * 512 * 2);
constexpr size_t kDNITEM = 73728;
constexpr size_t O_EDL = O_DN + (size_t)kNITEM * kDNITEM;
constexpr size_t O_BAR = O_EDL + al256((size_t)kNITEM * 4);
constexpr size_t O_END = O_BAR + 16384;
constexpr size_t O_OMLA = O_U;
constexpr size_t O_ODN = O_OMLA + (size_t)kRL * 512 * 2;
static_assert(O_ODN + (size_t)kRL * 512 * 2 <= O_CKV, "alias overflow");
static_assert((size_t)kNB * 32 * 4 * 2 * 32768 == 67108864, "state size");
constexpr size_t O_Y = O_PASS;
constexpr size_t O_U2 = O_Y + (size_t)32768 * 1024 * 2;
constexpr size_t O_H = O_U2 + (size_t)32768 * 1024 * 2;
static_assert(O_H + (size_t)32768 * kFF * 2 <= O_END, "post overflow");
static_assert(O_END <= (size_t)536870912, "workspace overflow");

struct Params {
  const float *x, *c, *ctx, *c_ctx, *w_mod, *b_mod, *g_pre_mix, *g_post_mix, *g_pre_ffn, *g_post_ffn, *w_in,
      *g_q_lora, *w_uq, *g_kv_lora, *w_ukv, *w_o_mla, *conv_qkv, *a_log, *dt_bias, *g_dn_out, *w_o_dn, *w_out,
      *w_ffn_in, *w_ffn_out;
  float* out;
  char* ws;
  int ph_lo, ph_hi;
};

DI int rtid() { int t = __builtin_amdgcn_workitem_id_x(); asm volatile("" : "+v"(t)); return t; }
DI int otid() { return rtid() & 255; }
DI int hid() { return __builtin_amdgcn_readfirstlane(__builtin_amdgcn_workitem_id_x() >> 8); }
DI int vbid() { return blockIdx.x * 2 + hid(); }
DI int vgrid() { return gridDim.x * 2; }
DI size_t ozero() { size_t z = 0; asm volatile("" : "+s"(z)); return z; }
DI unsigned pack2(float a, float b) {
  f2_t v = {a, b};
  bf2_t r = __builtin_convertvector(v, bf2_t);
  return __builtin_bit_cast(unsigned, r);
}
DI u16 f2bf(float a) { return (u16)(pack2(a, 0.f) & 0xffffu); }
DI float bflo(unsigned u) { return __uint_as_float(u << 16); }
DI float bfhi(unsigned u) { return __uint_as_float(u & 0xffff0000u); }
DI float bf2f(u16 v) { return __uint_as_float(((unsigned)v) << 16); }
DI float sigmoidf_(float x) { return __builtin_amdgcn_rcpf(1.f + __expf(-x)); }
DI float siluf_(float x) { return x * __builtin_amdgcn_rcpf(1.f + __expf(-x)); }
DI float shx(float v, int mask, int lane) {
  return __int_as_float(__builtin_amdgcn_ds_bpermute((lane ^ mask) << 2, __float_as_int(v)));
}
DI float shup(float v, int o, int lane) {
  return __int_as_float(__builtin_amdgcn_ds_bpermute((lane - o) << 2, __float_as_int(v)));
}
DI float wave_sum(float v, int lane) {
#pragma unroll
  for (int o = 32; o >= 1; o >>= 1) v += shx(v, o, lane);
  return v;
}
DI bf16x8 pack8(const f32x16& x, int s) {
  uint4 p;
  p.x = pack2(x[8 * s + 0], x[8 * s + 1]);
  p.y = pack2(x[8 * s + 2], x[8 * s + 3]);
  p.z = pack2(x[8 * s + 4], x[8 * s + 5]);
  p.w = pack2(x[8 * s + 6], x[8 * s + 7]);
  return __builtin_bit_cast(bf16x8, p);
}
DI bf16x8 cat8(uint2 lo, uint2 hi) {
  uint4 p = {lo.x, lo.y, hi.x, hi.y};
  return __builtin_bit_cast(bf16x8, p);
}
DI float bfsel(const uint4& u, int e) {
  const unsigned w = (e >> 1) == 0 ? u.x : ((e >> 1) == 1 ? u.y : ((e >> 1) == 2 ? u.z : u.w));
  return (e & 1) ? bfhi(w) : bflo(w);
}
DI int crow(int i, int h) { return (i & 3) + 8 * (i >> 2) + 4 * h; }


#define XB_TMO      128
#define XB_XCNT(j)  (256  + 64 * (j))
#define XB_XSUB(j)  (1280 + 64 * (j))
#define XB_XGEN(j)  (2304 + 64 * (j))
#define XB_TOP      3328
#define XB_TOPGEN   3392
#define XCD_BAR_WORDS 3456
#define XB_SPIN_CAP (1u << 20)
#define LAS __attribute__((address_space(3)))
DI unsigned xb_ld(unsigned* p) { return __hip_atomic_load(p, __ATOMIC_RELAXED, __HIP_MEMORY_SCOPE_AGENT); }
DI unsigned xb_add(unsigned* p, unsigned v) { return __hip_atomic_fetch_add(p, v, __ATOMIC_RELAXED, __HIP_MEMORY_SCOPE_AGENT); }
DI unsigned xb_xcc_id() { return (unsigned)__builtin_amdgcn_s_getreg((3 << 11) | 20) & 0xFu; }
#define XB_SPIN(cond, bar) do { unsigned _sp = 0; while (cond) { __builtin_amdgcn_s_sleep(1); \
    if ((++_sp & 255u) == 0u) { if (xb_ld(&(bar)[XB_TMO])) break; if (_sp > XB_SPIN_CAP) { atomicAdd(&(bar)[XB_TMO], 1u); break; } } } } while (0)
struct XcdBarrier {
  unsigned* bar;
  unsigned x;
  volatile LAS unsigned* st;
};
DI XcdBarrier xcd_barrier_post(unsigned* bar, volatile LAS unsigned* st) {
  XcdBarrier b;
  b.bar = bar;
  b.x = xb_xcc_id();
  b.st = st;
  if (__builtin_amdgcn_workitem_id_x() == 0) (void)xb_add(&bar[XB_XCNT(b.x)], 1u);
  return b;
}
DI void xcd_barrier_complete(unsigned* bar, unsigned x, unsigned& nloc, unsigned& nx) {
  const unsigned G = gridDim.x * gridDim.y * gridDim.z;
  unsigned sum, cnt, mine, sp = 0u;
  for (;;) {
    sum = 0u; cnt = 0u; mine = 0u;
#pragma unroll
    for (unsigned j = 0; j < 16; ++j) {
      const unsigned c = xb_ld(&bar[XB_XCNT(j)]);
      sum += c;
      cnt += (c > 0u) ? 1u : 0u;
      mine = (j == x) ? c : mine;
    }
    if (sum == G) break;
    __builtin_amdgcn_s_sleep(1);
    if ((++sp & 255u) == 0u) {
      if (xb_ld(&bar[XB_TMO])) break;
      if (sp > XB_SPIN_CAP) { atomicAdd(&bar[XB_TMO], 1u); break; }
    }
  }
  nloc = mine > 0u ? mine : 1u;
  nx = cnt > 0u ? cnt : 1u;
}
DI void xcd_barrier(const XcdBarrier& b) {
  asm volatile("s_waitcnt vmcnt(0)" ::: "memory");
  __syncthreads();
  if (__builtin_amdgcn_workitem_id_x() == 0) {
    typedef __attribute__((address_space(1))) unsigned gu32_t;
    gu32_t* gb_ = (gu32_t*)b.bar;
    asm volatile("" : "+s"(gb_));
    unsigned* bar = (unsigned*)gb_;
    __builtin_amdgcn_s_waitcnt(0);
    unsigned nloc = b.st[0], nx = b.st[1];
    if (nloc == 0u) { xcd_barrier_complete(bar, b.x, nloc, nx); b.st[0] = nloc; b.st[1] = nx; }
    const unsigned old = xb_add(&bar[XB_XSUB(b.x)], 1u);
    const unsigned gen = old / nloc;
    if (old + 1u == (gen + 1u) * nloc) {
      __builtin_amdgcn_fence(__ATOMIC_RELEASE, "agent");
      asm volatile("s_waitcnt vmcnt(0)" ::: "memory");
      const unsigned og = xb_add(&bar[XB_TOP], 1u);
      const unsigned tg = og / nx;
      if (og + 1u == (tg + 1u) * nx) xb_add(&bar[XB_TOPGEN], 1u);
      else XB_SPIN(xb_ld(&bar[XB_TOPGEN]) == tg, bar);
      __builtin_amdgcn_fence(__ATOMIC_ACQUIRE, "agent");
      xb_add(&bar[XB_XGEN(b.x)], 1u);
      asm volatile("s_waitcnt vmcnt(0)" ::: "memory");
    } else {
      XB_SPIN(xb_ld(&bar[XB_XGEN(b.x)]) == gen, bar);
      __builtin_amdgcn_fence(__ATOMIC_ACQUIRE, "agent");
      asm volatile("s_waitcnt vmcnt(0)" ::: "memory");
    }
  }
  __syncthreads();
}

using f32x4 = __attribute__((ext_vector_type(4))) float;
#define MFMA16(a, b, c) __builtin_amdgcn_mfma_f32_16x16x32_bf16((a), (b), (c), 0, 0, 0)
DI void stage_rc2(int b, int& R, int& C) {
  const int st = b >> 10, sb = b & 1023, swz = sb ^ (((sb >> 9) & 1) << 5);
  R = (st >> 1) * 16 + (swz >> 6);
  C = (st & 1) * 32 + ((swz & 63) >> 1);
}
template <bool SS>
DI void gemm256(f32x4 (&acc)[8][4], const u16* __restrict__ Ab, const u16* __restrict__ Bb, int K, char* shm,
                float (&ss)[8]) {
  const int tid = rtid(), wid = tid >> 6, lane = tid & 63, wr = wid >> 2, wc = wid & 3, fr = lane & 15, fq = lane >> 4;
  int o0;
  {
    int R, C;
    stage_rc2(wid * 1024 + lane * 16, R, C);
    o0 = R * K + C;
  }
  const int o1 = o0 + 64 * K, o2 = o0 + 128 * K, o3 = o0 + 192 * K;
  const int wo = wid * 1024 + lane * 16;
  const int lanepart = (fr * 64 + fq * 16) ^ ((fr >> 3) << 5);
  uint4 sa0, sa1, sa2, sa3, sb0, sb1, sb2, sb3;
#define G_ISSUE(kt)                                        \
  do {                                                     \
    const int ko_ = (kt) * 64;                             \
    sa0 = *(const uint4*)(Ab + o0 + ko_);                  \
    sb0 = *(const uint4*)(Bb + o0 + ko_);                  \
    sa1 = *(const uint4*)(Ab + o1 + ko_);                  \
    sb1 = *(const uint4*)(Bb + o1 + ko_);                  \
    sa2 = *(const uint4*)(Ab + o2 + ko_);                  \
    sb2 = *(const uint4*)(Bb + o2 + ko_);                  \
    sa3 = *(const uint4*)(Ab + o3 + ko_);                  \
    sb3 = *(const uint4*)(Bb + o3 + ko_);                  \
  } while (0)
#define G_WRITE(buf)                                       \
  do {                                                     \
    char* a_ = shm + (buf) * 65536 + wo;                   \
    *(uint4*)(a_) = sa0;                                   \
    *(uint4*)(a_ + 32768) = sb0;                           \
    *(uint4*)(a_ + 8192) = sa1;                            \
    *(uint4*)(a_ + 32768 + 8192) = sb1;                    \
    *(uint4*)(a_ + 16384) = sa2;                           \
    *(uint4*)(a_ + 32768 + 16384) = sb2;                   \
    *(uint4*)(a_ + 24576) = sa3;                           \
    *(uint4*)(a_ + 32768 + 24576) = sb3;                   \
  } while (0)
  const int nt = K >> 6;
  G_ISSUE(0);
  __syncthreads();
  G_WRITE(0);
  G_ISSUE(1);
  __syncthreads();
  for (int t = 0; t < nt; ++t) {
    const int cur = t & 1;
    if (t + 1 < nt) G_WRITE(cur ^ 1);
    if (t + 2 < nt) G_ISSUE(t + 2);
    const char* sAp = shm + cur * 65536 + wr * 16384 + lanepart;
    const char* sBp = shm + cur * 65536 + 32768 + wc * 8192 + lanepart;
#pragma unroll
    for (int ks = 0; ks < 2; ++ks) {
      bf16x8 Bf[4];
#pragma unroll
      for (int n = 0; n < 4; ++n) Bf[n] = *(const bf16x8*)(sBp + n * 2048 + ks * 1024);
#pragma unroll
      for (int mh = 0; mh < 2; ++mh) {
        bf16x8 At[4];
#pragma unroll
        for (int m = 0; m < 4; ++m) At[m] = *(const bf16x8*)(sAp + (mh * 4 + m) * 2048 + ks * 1024);
#pragma unroll
        for (int m = 0; m < 4; ++m)
#pragma unroll
          for (int n = 0; n < 4; ++n) acc[mh * 4 + m][n] = MFMA16(Bf[n], At[m], acc[mh * 4 + m][n]);
      }
    }
    __syncthreads();
  }
#undef G_ISSUE
#undef G_WRITE
}
DI float sq8(const uint4 u) {
  return bflo(u.x) * bflo(u.x) + bfhi(u.x) * bfhi(u.x) + bflo(u.y) * bflo(u.y) + bfhi(u.y) * bfhi(u.y) +
         bflo(u.z) * bflo(u.z) + bfhi(u.z) * bfhi(u.z) + bflo(u.w) * bflo(u.w) + bfhi(u.w) * bfhi(u.w);
}
DI void row_rstd256(const u16* __restrict__ A, int K, float* rs) {
  const int tid = rtid(), wid = tid >> 6, lane = tid & 63;
  __syncthreads();
  if (K == 512) {
#pragma unroll 1
    for (int b0 = 0; b0 < 32; b0 += 8) {
      uint4 u[8];
#pragma unroll
      for (int i = 0; i < 8; ++i) u[i] = *(const uint4*)(A + (size_t)(wid * 32 + b0 + i) * 512 + lane * 8);
#pragma unroll
      for (int i = 0; i < 8; ++i) {
        const float s = wave_sum(sq8(u[i]), lane);
        if (lane == 0) rs[wid * 32 + b0 + i] = rsqrtf(s * (1.f / 512.f) + kEPS);
      }
    }
  } else {
#pragma unroll 1
    for (int b0 = 0; b0 < 32; b0 += 16) {
      uint4 u[8];
#pragma unroll
      for (int i = 0; i < 8; ++i) u[i] = *(const uint4*)(A + (size_t)(wid * 32 + b0 + 2 * i + (lane >> 5)) * 256 + (lane & 31) * 8);
#pragma unroll
      for (int i = 0; i < 8; ++i) {
        float s = sq8(u[i]);
        s += shx(s, 1, lane); s += shx(s, 2, lane); s += shx(s, 4, lane); s += shx(s, 8, lane); s += shx(s, 16, lane);
        if ((lane & 31) == 0) rs[wid * 32 + b0 + 2 * i + (lane >> 5)] = rsqrtf(s * (1.f / 256.f) + kEPS);
      }
    }
  }
}
#define MEMFENCE() asm volatile("" ::: "memory")
DI void zero_acc(f32x4 (&acc)[8][4]) {
#pragma unroll
  for (int m = 0; m < 8; ++m)
#pragma unroll
    for (int n = 0; n < 4; ++n)
#pragma unroll
      for (int j = 0; j < 4; ++j) acc[m][n][j] = 0.f;
}
#define FOR_FRAG(m, n) _Pragma("unroll") for (int m = 0; m < 8; ++m) _Pragma("unroll") for (int n = 0; n < 4; ++n)

DI bool tile_of(int q, int nrt, int nct, int nranks, int scols, int& rt, int& ct, bool& done) {
  const int b = blockIdx.x;
  const int xcd = b & 7, rank = b >> 3;
  done = false;
  if (rank >= nranks) { done = true; return false; }
  const int srows = nranks / scols;
  const int nsc = (nct + scols - 1) / scols, nsr = (nrt + srows - 1) / srows;
  const int st = q * 8 + xcd;
  if (st >= nsr * nsc) { done = true; return false; }
  rt = (st / nsc) * srows + rank / scols;
  ct = (st % nsc) * scols + rank % scols;
  return rt < nrt && ct < nct && rank < srows * scols;
}
#define FOR_TILES_N(nrt, nct, nranks, scols, rt, ct)                   \
  for (int q_ = 0, rt = 0, ct = 0;; ++q_)                              \
    if (bool done_ = false; !tile_of(q_, (nrt), (nct), (nranks), (scols), rt, ct, done_)) { \
      if (done_) break;                                                \
    } else
DI int tile_scols(int nranks) { return (nranks & 3) == 0 ? 4 : 1; }
#define FOR_TILES(nrt, nct, rt, ct) FOR_TILES_N(nrt, nct, (gridDim.x >> 3), tile_scols(gridDim.x >> 3), rt, ct)

DI int colmap(int mode, int n) {
  if (mode == 0) return n;
  if (mode == 1) {
    if (n < 768) return n;
    if (n < 896) {
      int j = n - 768;
      if (j < 32) return 768 + j;
      if (j < 40) return 2848 + (j - 32);
      if (j < 48) return 2856 + (j - 40);
      return -1;
    }
    if (n < 2432) return 800 + (n - 896);
    if (n < 2944) return 2336 + (n - 2432);
    if (n < 4992) return 2864 + (n - 2944);
    return -1;
  }
  int blk = n >> 4, w = n & 15;
  return (blk & 1) * kFF + (blk >> 1) * 16 + w;
}
DI void conv_tile(const float* __restrict__ src, int K, int Nsrc, u16* __restrict__ dst, int mode,
                  const float* __restrict__ scale, int smask, int tk, int tn, float* tile  ) {
  const int tid = otid();
  const int k0 = tk * 64, n0 = tn * 64;
  __syncthreads();
  {
    const int nn = tid & 63;
    const int sc = colmap(mode, n0 + nn);
#pragma unroll 4
    for (int i = 0; i < 16; ++i) {
      const int kk = (tid >> 6) + 4 * i;
      float v = 0.f;
      if (sc >= 0) v = src[(size_t)(k0 + kk) * Nsrc + sc];
      if (scale) v *= scale[(k0 + kk) & smask];
      tile[kk * 65 + nn] = v;
    }
  }
  __syncthreads();
  {
    const int kk8 = (tid & 7) * 8;
#pragma unroll
    for (int i = 0; i < 2; ++i) {
      const int nn = (tid >> 3) + 32 * i;
      uint4 o;
      o.x = pack2(tile[(kk8 + 0) * 65 + nn], tile[(kk8 + 1) * 65 + nn]);
      o.y = pack2(tile[(kk8 + 2) * 65 + nn], tile[(kk8 + 3) * 65 + nn]);
      o.z = pack2(tile[(kk8 + 4) * 65 + nn], tile[(kk8 + 5) * 65 + nn]);
      o.w = pack2(tile[(kk8 + 6) * 65 + nn], tile[(kk8 + 7) * 65 + nn]);
      *(uint4*)(dst + (size_t)(n0 + nn) * K + k0 + kk8) = o;
    }
  }
}
DI void phase0(const Params& p, char* smem) {
  const int tid = otid();
  const int NT0 = 16 * 80, NT1 = 8 * 12, NT2 = 4 * 16, NT3 = 8 * 16, NT4 = 8 * 16, NT5 = 16 * 16, NT6 = 16 * 88,
            NT7 = 44 * 16;
  const int nconv = NT0 + NT1 + NT2 + NT3 + NT4 + NT5 + NT6 + NT7;
  const int nwork = 192 + 128 + nconv;
  for (int w2 = blockIdx.x; w2 < nwork / 2; w2 += gridDim.x) {
    const int w = 2 * w2 + hid();
    if (w < 192) {
      float* cs = (float*)smem;
      float* red = cs + 17 * 512;
      const int n0 = w * 32, nn = tid & 31, kg = tid >> 5;
      float a[17];
#pragma unroll
      for (int b = 0; b < 17; ++b) a[b] = 0.f;
      for (int half = 0; half < 2; ++half) {
        __syncthreads();
        for (int idx = tid; idx < 17 * 512; idx += 256) {
          int b = idx >> 9, kk = idx & 511, k = half * 512 + kk;
          float v = b < 16 ? p.c[b * 1024 + k] : p.c_ctx[k];
          cs[idx] = v / (1.f + expf(-v));
        }
        __syncthreads();
        for (int kk = kg * 64; kk < kg * 64 + 64; ++kk) {
          float wv = p.w_mod[(size_t)(half * 512 + kk) * 6144 + n0 + nn];
#pragma unroll
          for (int b = 0; b < 17; ++b) a[b] += cs[b * 512 + kk] * wv;
        }
      }
#pragma unroll
      for (int b = 0; b < 17; ++b) red[(kg * 17 + b) * 32 + nn] = a[b];
      __syncthreads();
      float* mod = (float*)(p.ws + O_MOD);
      for (int idx = tid; idx < 17 * 32; idx += 256) {
        int b = idx >> 5, n = idx & 31;
        float s = p.b_mod[n0 + n];
#pragma unroll
        for (int g = 0; g < 8; ++g) s += red[(g * 17 + b) * 32 + n];
        mod[b * 6144 + n0 + n] = s;
      }
      __syncthreads();
    } else if (w < 320) {
      float* rc = (float*)(p.ws + O_ROPE);
      float* rs = rc + 2048 * 16;
      int idx = (w - 192) * 256 + tid;
      int pos = idx >> 4, j = idx & 15, axis = j >> 3, f = j & 7;
      float inv = powf(10000.f, -(float)f / 8.f);
      float coord = (float)(axis == 0 ? (pos >> 6) : (pos & 63));
      float sn, cs;
      sincosf(coord * inv, &sn, &cs);
      rc[idx] = cs;
      rs[idx] = sn;
    } else {
      int t = w - 320;
      float* tile = (float*)smem;
      if (t < NT0) { conv_tile(p.w_in, 1024, 4912, (u16*)(p.ws + O_WIN), 1, nullptr, 0, t % 16, t / 16, tile); continue; }
      t -= NT0;
      if (t < NT1) { conv_tile(p.w_uq, 512, 768, (u16*)(p.ws + O_WUQ), 0, p.g_q_lora, 0xffff, t % 8, t / 8, tile); continue; }
      t -= NT1;
      if (t < NT2) { conv_tile(p.w_ukv, 256, 1024, (u16*)(p.ws + O_WUKV), 0, p.g_kv_lora, 0xffff, t % 4, t / 4, tile); continue; }
      t -= NT2;
      if (t < NT3) { conv_tile(p.w_o_mla, 512, 1024, (u16*)(p.ws + O_WOMLA), 0, nullptr, 0, t % 8, t / 8, tile); continue; }
      t -= NT3;
      if (t < NT4) { conv_tile(p.w_o_dn, 512, 1024, (u16*)(p.ws + O_WODN), 0, p.g_dn_out, 127, t % 8, t / 8, tile); continue; }
      t -= NT4;
      if (t < NT5) { conv_tile(p.w_out, 1024, 1024, (u16*)(p.ws + O_WOUT), 0, nullptr, 0, t % 16, t / 16, tile); continue; }
      t -= NT5;
      if (t < NT6) { conv_tile(p.w_ffn_in, 1024, 2 * kFF, (u16*)(p.ws + O_WFFI), 2, nullptr, 0, t % 16, t / 16, tile); continue; }
      t -= NT6;
      conv_tile(p.w_ffn_out, kFF, 1024, (u16*)(p.ws + O_WFFO), 0, nullptr, 0, t % 44, t / 44, tile);
    }
  }
}

typedef float nt_f4 __attribute__((ext_vector_type(4)));
typedef unsigned nt_u2 __attribute__((ext_vector_type(2)));
DI float4 ldnt_f4(const float* p) { nt_f4 v = __builtin_nontemporal_load((const nt_f4*)p); return make_float4(v.x, v.y, v.z, v.w); }
DI void stnt_f4(float* p, float4 v) { nt_f4 t = {v.x, v.y, v.z, v.w}; __builtin_nontemporal_store(t, (nt_f4*)p); }
DI uint2 ldnt_u2(const u16* p) { nt_u2 v = __builtin_nontemporal_load((const nt_u2*)p); return make_uint2(v.x, v.y); }
DI void phase1(const Params& p, int pass) {
  const int tid_ = rtid(); const int lane = tid_ & 63, wv = tid_ >> 6;
  const float* mod = (const float*)(p.ws + O_MOD);
  u16* U = (u16*)(p.ws + O_U);
  for (int row = blockIdx.x * 8 + wv; row < kR; row += gridDim.x * 8) {
    const int bl = row / kS, pos = row % kS, b = pass * kNB + bl;
    const float* src = pos < kT ? p.x + ((size_t)b * kT + pos) * kD : p.ctx + ((size_t)b * 256 + (pos - kT)) * kD;
    const float* md = mod + (pos < kT ? b : 16) * 6144;
    float4 v[4];
    float ss = 0.f;
#pragma unroll
    for (int i = 0; i < 4; ++i) {
      v[i] = ldnt_f4(src + i * 256 + lane * 4);
      ss += v[i].x * v[i].x + v[i].y * v[i].y + v[i].z * v[i].z + v[i].w * v[i].w;
    }
    ss = wave_sum(ss, lane);
    const float rstd = rsqrtf(ss * (1.f / 1024.f) + kEPS);
#pragma unroll
    for (int i = 0; i < 4; ++i) {
      const int k = i * 256 + lane * 4;
      float4 g = *(const float4*)(p.g_pre_mix + k), sh = *(const float4*)(md + k), sc = *(const float4*)(md + 1024 + k);
      uint2 o;
      o.x = pack2(v[i].x * rstd * g.x * (1.f + sc.x) + sh.x, v[i].y * rstd * g.y * (1.f + sc.y) + sh.y);
      o.y = pack2(v[i].z * rstd * g.z * (1.f + sc.z) + sh.z, v[i].w * rstd * g.w * (1.f + sc.w) + sh.w);
      *(uint2*)(U + (size_t)row * kD + k) = o;
    }
  }
}

DI void phase2(const Params& p, char* smem) {
  const u16* U = (const u16*)(p.ws + O_U);
  const u16* W = (const u16*)(p.ws + O_WIN);
  FOR_TILES(72, 20, rt, ct) {
    const int bl = rt / 9, tt = rt % 9;
    const bool isctx = tt == 8;
    if (isctx && !(ct >= 2 && ct <= 9)) continue;
    f32x4 acc[8][4];
    zero_acc(acc);
    float ss[8];
    gemm256<false>(acc, U + (size_t)rt * 256 * kD, W + (size_t)ct * 256 * kD, kD, smem, ss);
    const int tid = rtid(), wid = tid >> 6, lane = tid & 63, wr = wid >> 2, wc = wid & 3, fr = lane & 15, fq = lane >> 4;

    const int seg = ct * 2 + (wc >> 1);
    if (seg == 39 || (isctx && !(seg >= 4 && seg < 19))) continue;
    const int grow0 = rt * 256 + wr * 128 + fr;
    const int lrow0 = bl * kT + tt * 256 + wr * 128 + fr;
    const int cs0 = (wc & 1) * 64 + fq * 4;
    if (seg == 6) {
      float* SM = (float*)(p.ws + O_SM);
      FOR_FRAG(m, n) {
        const int col = cs0 + n * 16;
        if (col < 48) *(float4*)(SM + (size_t)(grow0 + m * 16) * 48 + col) = make_float4(acc[m][n][0], acc[m][n][1], acc[m][n][2], acc[m][n][3]);
      }
    } else {
      u16* dst;
      int ld, row0, c0;
      if (seg < 4) { dst = (u16*)(p.ws + O_CQ); ld = 512; row0 = lrow0; c0 = seg * 128; }
      else if (seg < 6) { dst = (u16*)(p.ws + O_CKV); ld = 256; row0 = grow0; c0 = (seg - 4) * 128; }
      else if (seg < 19) { dst = (u16*)(p.ws + O_QKV); ld = 1536; row0 = grow0; c0 = (seg - 7) * 128; }
      else if (seg < 23) { dst = (u16*)(p.ws + O_Z); ld = 512; row0 = lrow0; c0 = (seg - 19) * 128; }
      else if (seg < 31) { dst = (u16*)(p.ws + O_GA); ld = 1024; row0 = lrow0; c0 = (seg - 23) * 128; }
      else { dst = (u16*)(p.ws + O_GB); ld = 1024; row0 = lrow0; c0 = (seg - 31) * 128; }
      FOR_FRAG(m, n) {
        const uint2 o = {pack2(acc[m][n][0], acc[m][n][1]), pack2(acc[m][n][2], acc[m][n][3])};
        *(uint2*)(dst + (size_t)(row0 + m * 16) * ld + c0 + cs0 + n * 16) = o;
      }
    }
  }
}

DI void dn_intra(const Params& p, int item, char* smem) {
  const int tid = otid(), lane = tid & 63, wid = tid >> 6, r = lane & 31, h = lane >> 5;
  const int dir = item & 1, hd = (item >> 1) & 3, c = (item >> 3) % 36, bl = (item >> 3) / 36;
  const bool latent = c < 32;
  const int seq_lo = latent ? 0 : kT, seq_hi = latent ? kT : kS;
  const int base = c * 64;
  const size_t rowbase = (size_t)bl * kS;
  u16* Ks = (u16*)smem;
  u16* Qs = Ks + 64 * 136;
  u16* Vs = Qs + 64 * 136;
  float* L = (float*)Qs;
  float* gcs = (float*)(Vs + 64 * 136);
  float* bts = gcs + 64;
  float* sclk = bts + 64;
  const float* SM = (const float*)(p.ws + O_SM);
  const u16* QKV = (const u16*)(p.ws + O_QKV);
  char* ib = p.ws + O_DN + (size_t)item * kDNITEM;
  u16* UdT = (u16*)ib;
  u16* Wd = (u16*)(ib + 16384);
  u16* KdT = (u16*)(ib + 32768);
  u16* Qg = (u16*)(ib + 49152);
  u16* QKd = (u16*)(ib + 65536);
  __syncthreads();
  float* cwS = sclk + 64 + 48 * 64;
  for (int x = tid; x < 288; x += 256) {
    const int j = x / 96, q = x % 96;
    *(float4*)(cwS + j * 384 + q * 4) = *(const float4*)(p.conv_qkv + j * 1536 + (q >> 5) * 512 + hd * 128 + (q & 31) * 4);
  }
  if (wid == 0) {
    const int pos = base + (dir ? 63 - lane : lane);
    const float* smr = SM + (rowbase + pos) * 48;
    const float beta = sigmoidf_(smr[32 + dir * 4 + hd]);
    const float al = smr[40 + dir * 4 + hd] + p.dt_bias[dir * 4 + hd];
    const float te = __expf(al);
    const float sp = al > 15.f ? al : (te < 0.01f ? te * (1.f - te * (0.5f - te * (1.f / 3.f))) : __logf(1.f + te));
    float g = -__expf(p.a_log[dir * 4 + hd]) * sp;
#pragma unroll
    for (int o = 1; o < 64; o <<= 1) {
      float t = shup(g, o, lane);
      if (lane >= o) g += t;
    }
    gcs[lane] = g;
    bts[lane] = beta;
    sclk[lane] = beta * __expf(g);
  }
  __syncthreads();
  {
    const int hf = hid();
    char* sm0 = smem - hf * 73728;
    char* ib0 = p.ws + O_DN + (size_t)(item & ~1) * kDNITEM;
    uint4 U0[6], U1[6], U2[6];
#pragma unroll
    for (int k = 0; k < 6; ++k) {
      const int idx = hf * 1536 + k * 256 + tid;
      const int i = idx / 48, cg_ = idx % 48, seg = cg_ >> 4, cc = (cg_ & 15) * 8;
      const int pos = base + i;
      const u16* rp = QKV + (rowbase + pos) * 1536 + seg * 512 + hd * 128 + cc;
      U1[k] = *(const uint4*)rp;
      U0[k] = make_uint4(0, 0, 0, 0);
      U2[k] = make_uint4(0, 0, 0, 0);
      if (pos - 1 >= seq_lo) U0[k] = *(const uint4*)(rp - 1536);
      if (pos + 1 < seq_hi) U2[k] = *(const uint4*)(rp + 1536);
    }
#pragma unroll
    for (int k = 0; k < 6; ++k) {
      const int idx = hf * 1536 + k * 256 + tid;
      const int i = idx / 48, cg_ = idx % 48, seg = cg_ >> 4, cc = (cg_ & 15) * 8;
      const float* cw = cwS + seg * 128 + cc;
      float w0[8], w1[8], w2[8];
      *(float4*)&w0[0] = *(const float4*)(cw);        *(float4*)&w0[4] = *(const float4*)(cw + 4);
      *(float4*)&w1[0] = *(const float4*)(cw + 384);  *(float4*)&w1[4] = *(const float4*)(cw + 388);
      *(float4*)&w2[0] = *(const float4*)(cw + 768);  *(float4*)&w2[4] = *(const float4*)(cw + 772);
      float v[8];
      float ssq = 0.f;
#pragma unroll
      for (int e = 0; e < 8; ++e) {
        const float x0 = bfsel(U0[k], e), x1 = bfsel(U1[k], e), x2 = bfsel(U2[k], e);
        float cv = x0 * w0[e] + x1 * w1[e] + x2 * w2[e];
        cv = siluf_(cv);
        v[e] = cv;
        ssq += cv * cv;
      }
      ssq += shx(ssq, 8, lane);
      ssq += shx(ssq, 4, lane);
      ssq += shx(ssq, 2, lane);
      ssq += shx(ssq, 1, lane);
      const float sc = seg < 2 ? rsqrtf(ssq + kEPS) : 1.f;
#pragma unroll
      for (int e = 0; e < 8; ++e) v[e] *= sc;
      const uint4 o = {pack2(v[0], v[1]), pack2(v[2], v[3]), pack2(v[4], v[5]), pack2(v[6], v[7])};
      const int tofs = (seg == 0 ? 64 * 136 : (seg == 1 ? 0 : 2 * 64 * 136));
#pragma unroll
      for (int d = 0; d < 2; ++d) {
        const int rowd = d ? 63 - i : i;
        char* smd = sm0 + d * 73728;
        *(uint4*)((u16*)smd + tofs + rowd * 136 + cc) = o;
        if (seg == 0 && latent) {
          const float qs = __expf(((const float*)(smd + 52224))[rowd]) * kDKS;
          const uint4 o2 = {pack2(v[0] * qs, v[1] * qs), pack2(v[2] * qs, v[3] * qs), pack2(v[4] * qs, v[5] * qs),
                            pack2(v[6] * qs, v[7] * qs)};
          *(uint4*)((u16*)(ib0 + (size_t)d * kDNITEM + 49152) + rowd * 128 + cc) = o2;
        }
      }
    }
  }
  __syncthreads();
  const int bi = wid >> 1, bj = wid & 1;
  f32x16 akk, aqk;
#pragma unroll
  for (int i = 0; i < 16; ++i) { akk[i] = 0.f; aqk[i] = 0.f; }
#pragma unroll
  for (int ks = 0; ks < 8; ++ks) {
    bf16x8 ak = *(const bf16x8*)(Ks + (bi * 32 + r) * 136 + ks * 16 + h * 8);
    bf16x8 aq = *(const bf16x8*)(Qs + (bi * 32 + r) * 136 + ks * 16 + h * 8);
    bf16x8 bk = *(const bf16x8*)(Ks + (bj * 32 + r) * 136 + ks * 16 + h * 8);
    akk = MFMA32(ak, bk, akk);
    aqk = MFMA32(aq, bk, aqk);
  }
  __syncthreads();
  {
    const int col = bj * 32 + r;
    const float gcc = gcs[col];
#pragma unroll
    for (int i = 0; i < 16; ++i) {
      const int row = bi * 32 + crow(i, h);
      const float gr = gcs[row];
      const float dec = __expf(fminf(gr - gcc, 0.f));
      L[row * 64 + col] = row > col ? akk[i] * bts[row] * dec : 0.f;
      if (latent) QKd[row * 64 + col] = f2bf(row >= col ? aqk[i] * kDKS * dec : 0.f);
    }
  }
  __syncthreads();
  {
    const int widu = __builtin_amdgcn_readfirstlane(wid);
    float* Tf = sclk + 64;
    float* Pw = Tf + 4096 + widu * 256;
    for (int x = tid; x < 6 * 256; x += 256) {
      const int blk = x >> 8, e = x & 255;
      const int I = blk < 3 ? 0 : (blk < 5 ? 1 : 2), J = blk < 3 ? blk + 1 : (blk < 5 ? blk - 1 : 3);
      Tf[(16 * I + (e >> 4)) * 64 + 16 * J + (e & 15)] = 0.f;
    }
    {
      const int c = lane & 15, I = widu;
      float lrow[16], acc[16];
#pragma unroll
      for (int ii = 0; ii < 16; ++ii) {
        lrow[ii] = L[(16 * I + ii) * 64 + 16 * I + c];
        acc[ii] = (ii == c) ? 1.f : 0.f;
      }
#pragma unroll
      for (int ii = 1; ii < 16; ++ii)
#pragma unroll
        for (int j = 0; j < ii; ++j)
          acc[ii] -= __int_as_float(__builtin_amdgcn_readlane(__float_as_int(lrow[ii]), j)) * acc[j];
      if (lane < 16) {
#pragma unroll
        for (int ii = 0; ii < 16; ++ii) Tf[(16 * I + ii) * 64 + 16 * I + c] = acc[ii];
      }
    }
    __syncthreads();
    const int l15 = lane & 15, l4 = lane >> 4;
#define MM16(accv, Ap, lda, Bp, ldb)                                                                   \
  _Pragma("unroll") for (int kk = 0; kk < 4; ++kk)                                                     \
    accv = __builtin_amdgcn_mfma_f32_16x16x4f32((Ap)[l15 * (lda) + 4 * kk + l4], (Bp)[(4 * kk + l4) * (ldb) + l15], accv, 0, 0, 0)
#define SOLVE_BLOCK(I, J)                                                                              \
  do {                                                                                                 \
    f32x4 P_ = {0.f, 0.f, 0.f, 0.f};                                                                   \
    for (int K_ = (J); K_ < (I); ++K_) MM16(P_, L + (16 * (I)) * 64 + 16 * K_, 64, Tf + (16 * K_) * 64 + 16 * (J), 64); \
    _Pragma("unroll") for (int i = 0; i < 4; ++i) Pw[(4 * l4 + i) * 16 + l15] = P_[i];                 \
    f32x4 R_ = {0.f, 0.f, 0.f, 0.f};                                                                   \
    MM16(R_, Tf + (16 * (I)) * 64 + 16 * (I), 64, Pw, 16);                                             \
    _Pragma("unroll") for (int i = 0; i < 4; ++i) Tf[(16 * (I) + 4 * l4 + i) * 64 + 16 * (J) + l15] = -R_[i]; \
  } while (0)
    if (widu < 3) SOLVE_BLOCK(widu + 1, widu);
    __syncthreads();
    if (widu < 2) SOLVE_BLOCK(widu + 2, widu);
    __syncthreads();
    if (widu == 0) SOLVE_BLOCK(3, 0);
    __syncthreads();
#undef SOLVE_BLOCK
#undef MM16
    u16* Tl = (u16*)L;
    for (int x = tid; x < 4096; x += 256) {
      const int i = x >> 6, c = x & 63;
      const float t = Tf[i * 64 + c];
      Tl[i * 128 + c] = f2bf(t * bts[c]);
      Tl[i * 128 + 64 + c] = f2bf(t * sclk[c]);
    }
  }
  __syncthreads();
  {
    const u16* Tl = (const u16*)L;
    const int cb = wid * 32;
    f32x16 au[2], aw[2];
#pragma unroll
    for (int m = 0; m < 2; ++m)
#pragma unroll
      for (int i = 0; i < 16; ++i) { au[m][i] = 0.f; aw[m][i] = 0.f; }
#pragma unroll
    for (int s = 0; s < 4; ++s) {
      bf16x8 bv, ak;
#pragma unroll
      for (int jj = 0; jj < 8; ++jj) {
        bv[jj] = (short)Vs[(16 * s + 8 * h + jj) * 136 + cb + r];
        ak[jj] = (short)Ks[(16 * s + 8 * h + jj) * 136 + cb + r];
      }
#pragma unroll
      for (int m = 0; m < 2; ++m) {
        const bf16x8 tv = *(const bf16x8*)(Tl + (32 * m + r) * 128 + 16 * s + 8 * h);
        const bf16x8 tk = *(const bf16x8*)(Tl + (32 * m + r) * 128 + 64 + 16 * s + 8 * h);
        au[m] = MFMA32(tv, bv, au[m]);
        aw[m] = MFMA32(ak, tk, aw[m]);
      }
    }
#pragma unroll
    for (int m = 0; m < 2; ++m)
#pragma unroll
      for (int g = 0; g < 4; ++g) {
        uint2 ou = {pack2(au[m][4 * g], au[m][4 * g + 1]), pack2(au[m][4 * g + 2], au[m][4 * g + 3])};
        *(uint2*)(UdT + (cb + r) * 64 + 32 * m + 8 * g + 4 * h) = ou;
        uint2 ow = {pack2(-aw[m][4 * g], -aw[m][4 * g + 1]), pack2(-aw[m][4 * g + 2], -aw[m][4 * g + 3])};
        *(uint2*)(Wd + (32 * m + r) * 128 + cb + 8 * g + 4 * h) = ow;
      }
  }
  {
    const int dk = tid & 127, ih = tid >> 7;
    const float gl = gcs[63];
#pragma unroll
    for (int q = 0; q < 4; ++q) {
      float t[8];
#pragma unroll
      for (int e = 0; e < 8; ++e) {
        const int i = ih * 32 + q * 8 + e;
        t[e] = bf2f(Ks[i * 136 + dk]) * __expf(gl - gcs[i]);
      }
      uint4 o = {pack2(t[0], t[1]), pack2(t[2], t[3]), pack2(t[4], t[5]), pack2(t[6], t[7])};
      *(uint4*)(KdT + dk * 64 + ih * 32 + q * 8) = o;
    }
    if (tid == 0) ((float*)(p.ws + O_EDL))[item] = __expf(gl);
  }
}

DI void qproj_tile(const Params& p, int rt, int ct, char* smem) {
  f32x4 acc[8][4];
  zero_acc(acc);
  float ss[8];
  float* rs = (float*)(smem + 131072);
  row_rstd256((const u16*)(p.ws + O_CQ) + (size_t)rt * 256 * 512, 512, rs);
  gemm256<false>(acc, (const u16*)(p.ws + O_CQ) + (size_t)rt * 256 * 512, (const u16*)(p.ws + O_WUQ) + (size_t)ct * 256 * 512,
                 512, smem, ss);
    const int tid = rtid(), wid = tid >> 6, lane = tid & 63, wr = wid >> 2, wc = wid & 3, fr = lane & 15, fq = lane >> 4;

  const float* rc = (const float*)(p.ws + O_ROPE);
  const float* rsn = rc + 2048 * 16;
  u16* Q = (u16*)(p.ws + O_Q);
#pragma unroll
  for (int m = 0; m < 8; ++m) {
    MEMFENCE();
    const float rstd = rs[wr * 128 + m * 16 + fr];
    const int lrow = rt * 256 + wr * 128 + m * 16 + fr;
    const int t = lrow & (kT - 1), bl = lrow >> 11;
#pragma unroll
    for (int n = 0; n < 4; ++n) {
      const int gc = ct * 256 + wc * 64 + n * 16 + fq * 4;
      const int hq = gc / 96, d = gc % 96;
      float v[4];
#pragma unroll
      for (int j = 0; j < 4; ++j) v[j] = acc[m][n][j] * rstd;
      if (((ct * 256 + wc * 64 + n * 16) % 96) >= 64) {
        float pv[4];
#pragma unroll
        for (int j = 0; j < 4; ++j) pv[j] = shx(v[j], 32, lane);
        const int e0 = d - 64;
        const int axis = e0 >> 4, upper = (e0 >> 3) & 1;
        const float4 cs4 = *(const float4*)(rc + t * 16 + axis * 8 + (e0 & 7));
        const float4 sn4 = *(const float4*)(rsn + t * 16 + axis * 8 + (e0 & 7));
        const float csv[4] = {cs4.x, cs4.y, cs4.z, cs4.w}, snv[4] = {sn4.x, sn4.y, sn4.z, sn4.w};
#pragma unroll
        for (int j = 0; j < 4; ++j) v[j] = upper ? (pv[j] * snv[j] + v[j] * csv[j]) : (v[j] * csv[j] - pv[j] * snv[j]);
      }
      const uint2 o = {pack2(v[0] * kQSCALE, v[1] * kQSCALE), pack2(v[2] * kQSCALE, v[3] * kQSCALE)};
      *(uint2*)(Q + (((size_t)bl * 8 + hq) * kT + t) * 96 + d) = o;
    }
  }
}
DI void kvproj_tile(const Params& p, int rt, int ct, char* smem) {
  f32x4 acc[8][4];
  zero_acc(acc);
  float ss[8];
  float* rs = (float*)(smem + 131072);
  row_rstd256((const u16*)(p.ws + O_CKV) + (size_t)rt * 256 * 256, 256, rs);
  gemm256<false>(acc, (const u16*)(p.ws + O_CKV) + (size_t)rt * 256 * 256, (const u16*)(p.ws + O_WUKV) + (size_t)ct * 256 * 256,
                 256, smem, ss);
    const int tid = rtid(), wid = __builtin_amdgcn_readfirstlane(tid >> 6), lane = tid & 63, wr = wid >> 2, wc = wid & 3, fr = lane & 15,
            fq = lane >> 4;

  const int bl = rt / 9, pos0 = (rt % 9) * 256;
  const int hk = ct * 2 + (wc >> 1);
  u16* Kb = (u16*)(p.ws + O_K) + ((size_t)bl * 8 + hk) * kS * 96;
  u16* Vb = (u16*)(p.ws + O_VT) + ((size_t)bl * 8 + hk) * 64 * kS;
  if ((wc & 1) == 0) {
#pragma unroll
    for (int m = 0; m < 8; ++m) {
      MEMFENCE();
      const float rstd = rs[wr * 128 + m * 16 + fr];
      const int pos = pos0 + wr * 128 + m * 16 + fr;
#pragma unroll
      for (int n = 0; n < 4; ++n) {
        const uint2 o = {pack2(acc[m][n][0] * rstd, acc[m][n][1] * rstd), pack2(acc[m][n][2] * rstd, acc[m][n][3] * rstd)};
        *(uint2*)(Kb + (size_t)pos * 96 + n * 16 + fq * 4) = o;
      }
    }
  } else {
    const int q0 = lane & 1, q1 = (lane >> 1) & 1;
#pragma unroll
    for (int m = 0; m < 8; ++m) {
      MEMFENCE();
      const float rstd = rs[wr * 128 + m * 16 + fr];
      const int pos4 = pos0 + wr * 128 + m * 16 + (fr & ~3);
#pragma unroll
      for (int n = 0; n < 4; ++n) {
        float v0 = acc[m][n][0] * rstd, v1 = acc[m][n][1] * rstd, v2 = acc[m][n][2] * rstd, v3 = acc[m][n][3] * rstd;
        {
          const float s01 = q0 ? v0 : v1, s23 = q0 ? v2 : v3;
          const float r01 = __int_as_float(__builtin_amdgcn_mov_dpp(__float_as_int(s01), 0xB1, 0xF, 0xF, true));
          const float r23 = __int_as_float(__builtin_amdgcn_mov_dpp(__float_as_int(s23), 0xB1, 0xF, 0xF, true));
          if (q0) { v0 = r01; v2 = r23; } else { v1 = r01; v3 = r23; }
        }
        {
          const float s02 = q1 ? v0 : v2, s13 = q1 ? v1 : v3;
          const float r02 = __int_as_float(__builtin_amdgcn_mov_dpp(__float_as_int(s02), 0x4E, 0xF, 0xF, true));
          const float r13 = __int_as_float(__builtin_amdgcn_mov_dpp(__float_as_int(s13), 0x4E, 0xF, 0xF, true));
          if (q1) { v0 = r02; v1 = r13; } else { v2 = r02; v3 = r13; }
        }
        const uint2 o = {pack2(v0, v1), pack2(v2, v3)};
        *(uint2*)(Vb + (size_t)(n * 16 + fq * 4 + (fr & 3)) * kS + pos4) = o;
      }
    }
  }
  if (ct == 0) {
    const float* SM = (const float*)(p.ws + O_SM);
    const float* rc = (const float*)(p.ws + O_ROPE);
    const float* rsn = rc + 2048 * 16;
    const int row = tid >> 1, axis = tid & 1;
    const int pos = pos0 + row;
    const float* kr = SM + ((size_t)bl * kS + pos) * 48 + axis * 16;
    float o[16];
#pragma unroll
    for (int f = 0; f < 8; ++f) {
      const float x1 = kr[f], x2 = kr[8 + f];
      if (pos < kT) {
        const float cs = rc[pos * 16 + axis * 8 + f], sn = rsn[pos * 16 + axis * 8 + f];
        o[f] = x1 * cs - x2 * sn;
        o[8 + f] = x1 * sn + x2 * cs;
      } else {
        o[f] = x1;
        o[8 + f] = x2;
      }
    }
    uint4 o0 = {pack2(o[0], o[1]), pack2(o[2], o[3]), pack2(o[4], o[5]), pack2(o[6], o[7])};
    uint4 o1 = {pack2(o[8], o[9]), pack2(o[10], o[11]), pack2(o[12], o[13]), pack2(o[14], o[15])};
#pragma unroll
    for (int hh = 0; hh < 8; ++hh) {
      u16* d = (u16*)(p.ws + O_K) + (((size_t)bl * 8 + hh) * kS + pos) * 96 + 64 + axis * 16;
      *(uint4*)d = o0;
      *(uint4*)(d + 8) = o1;
    }
  }
}
DI void phase3(const Params& p, char* smemh) {
  for (int w2 = blockIdx.x; w2 < kNITEM / 2; w2 += gridDim.x) dn_intra(p, 2 * w2 + hid(), smemh);
}

DI void st8(u16* d, uint4 v) {
  *(uint2*)d = make_uint2(v.x, v.y);
  *(uint2*)(d + 4) = make_uint2(v.z, v.w);
}
DI void dn_scan(const Params& p, int sb, char* smem) {
  const int tid = otid(), lane = tid & 63, wid = tid >> 6, r = lane & 31, h = lane >> 5;
  const int dir = sb & 1, hd = (sb >> 1) & 3, bl = sb >> 3;
  const int dvb = wid * 32;
  u16* sW = (u16*)smem;
  u16* sK = sW + 64 * 132;
  const float* EDL = (const float*)(p.ws + O_EDL);
  f32x16 S[4];
#pragma unroll
  for (int k = 0; k < 4; ++k)
#pragma unroll
    for (int i = 0; i < 16; ++i) S[k][i] = 0.f;
  uint4 pw[4], pk[4];
  uint2 pu[8];
  auto chunk_of = [&](int step) {
    return step < 4 ? (dir ? 35 - step : 32 + step) : (dir ? 31 - (step - 4) : (step - 4));
  };
  auto prefetch = [&](int step) {
    const int c = chunk_of(step);
    const int item = (((bl * 36 + c) * 4 + hd) << 1) | dir;
    const char* ib = p.ws + O_DN + (size_t)item * kDNITEM;
#pragma unroll
    for (int i = 0; i < 4; ++i) {
      pw[i] = *(const uint4*)(ib + 16384 + (size_t)(i * 256 + tid) * 16);
      pk[i] = *(const uint4*)(ib + 32768 + (size_t)(i * 256 + tid) * 16);
    }
    const u16* UdT = (const u16*)ib;
#pragma unroll
    for (int mb = 0; mb < 2; ++mb)
#pragma unroll
      for (int g = 0; g < 4; ++g) pu[mb * 4 + g] = *(const uint2*)(UdT + (dvb + r) * 64 + mb * 32 + 8 * g + 4 * h);
  };
  __syncthreads();
  prefetch(0);
  for (int step = 0; step < 36; ++step) {
    const int c = chunk_of(step);
    const bool lat = c < 32;
    const int item = (((bl * 36 + c) * 4 + hd) << 1) | dir;
#pragma unroll
    for (int i = 0; i < 4; ++i) {
      const int ch = i * 256 + tid;
      st8(sW + (ch >> 4) * 132 + (ch & 15) * 8, pw[i]);
      st8(sK + (ch >> 3) * 68 + (ch & 7) * 8, pk[i]);
    }
    f32x16 vn[2];
#pragma unroll
    for (int mb = 0; mb < 2; ++mb)
#pragma unroll
      for (int g = 0; g < 4; ++g) {
        const uint2 u = pu[mb * 4 + g];
        vn[mb][4 * g + 0] = bflo(u.x);
        vn[mb][4 * g + 1] = bfhi(u.x);
        vn[mb][4 * g + 2] = bflo(u.y);
        vn[mb][4 * g + 3] = bfhi(u.y);
      }
    const float edl = EDL[item];
    __syncthreads();
    if (step + 1 < 36) prefetch(step + 1);
    const int sidx = (((bl * 32 + (c & 31)) * 4 + hd) << 1) | dir;
    u16* STf = (u16*)((char*)p.out + 67108864) + (size_t)sidx * 16384 + wid * 4096 + lane * 8;
#pragma unroll
    for (int kb = 0; kb < 4; ++kb)
#pragma unroll
      for (int s = 0; s < 2; ++s) {
        const bf16x8 bS = pack8(S[kb], s);
        if (lat) *(bf16x8*)(STf + (kb * 2 + s) * 512) = bS;
        const int ko = kb * 32 + s * 16 + 4 * h;
#pragma unroll
        for (int mb = 0; mb < 2; ++mb) {
          const u16* wp = sW + (mb * 32 + r) * 132 + ko;
          vn[mb] = MFMA32(cat8(*(const uint2*)wp, *(const uint2*)(wp + 8)), bS, vn[mb]);
        }
      }
    u16* Vf = (u16*)(p.ws + O_DN + (size_t)item * kDNITEM) + wid * 2048 + lane * 8;
#pragma unroll
    for (int k = 0; k < 4; ++k)
#pragma unroll
      for (int i = 0; i < 16; ++i) S[k][i] *= edl;
#pragma unroll
    for (int kb2 = 0; kb2 < 2; ++kb2)
#pragma unroll
      for (int s = 0; s < 2; ++s) {
        const bf16x8 bV = pack8(vn[kb2], s);
        if (lat) *(bf16x8*)(Vf + (kb2 * 2 + s) * 512) = bV;
        const int ko = kb2 * 32 + s * 16 + 4 * h;
#pragma unroll
        for (int dkb = 0; dkb < 4; ++dkb) {
          const u16* kp = sK + (dkb * 32 + r) * 68 + ko;
          S[dkb] = MFMA32(cat8(*(const uint2*)kp, *(const uint2*)(kp + 8)), bV, S[dkb]);
        }
      }
    __syncthreads();
  }
}

DI void attn_item(const Params& p, int w, char* smem) {
  const int tid = otid(), lane = tid & 63, wid = tid >> 6, r = lane & 31, h = lane >> 5;
  const int qb = w & 15, hh = (w >> 4) & 7, bl = w >> 7;
  const u16* Qp = (const u16*)(p.ws + O_Q) + (((size_t)bl * 8 + hh) * kT + qb * 128) * 96;
  const u16* Kp = (const u16*)(p.ws + O_K) + ((size_t)bl * 8 + hh) * kS * 96;
  const u16* Vp = (const u16*)(p.ws + O_VT) + ((size_t)bl * 8 + hh) * 64 * kS;
  u16* sKb = (u16*)smem;
  u16* sVb = sKb + 2 * 64 * 104;
  bf16x8 qf[6];
#pragma unroll
  for (int ks = 0; ks < 6; ++ks) qf[ks] = *(const bf16x8*)(Qp + (size_t)(wid * 32 + r) * 96 + ks * 16 + h * 8);
  f32x16 o[2];
#pragma unroll
  for (int d = 0; d < 2; ++d)
#pragma unroll
    for (int i = 0; i < 16; ++i) o[d][i] = 0.f;
  float m = -INFINITY, l = 0.f;
  uint4 rk0, rk1, rk2, rv0, rv1;
#define ATT_GLOAD(kt)                                                                              \
  do {                                                                                             \
    const u16* kp_ = Kp + (size_t)(kt) * 64 * 96 + (size_t)tid * 8;                                \
    rk0 = *(const uint4*)(kp_);                                                                    \
    rk1 = *(const uint4*)(kp_ + 2048);                                                             \
    rk2 = *(const uint4*)(kp_ + 4096);                                                             \
    rv0 = *(const uint4*)(Vp + (size_t)(tid >> 3) * kS + (kt) * 64 + (tid & 7) * 8);               \
    rv1 = *(const uint4*)(Vp + (size_t)((tid + 256) >> 3) * kS + (kt) * 64 + (tid & 7) * 8);       \
  } while (0)
#define ATT_LSTORE(buf)                                                                            \
  do {                                                                                             \
    u16* kb_ = sKb + (buf) * 64 * 104;                                                             \
    *(uint4*)(kb_ + (tid / 12) * 104 + (tid % 12) * 8) = rk0;                                      \
    *(uint4*)(kb_ + ((tid + 256) / 12) * 104 + ((tid + 256) % 12) * 8) = rk1;                      \
    *(uint4*)(kb_ + ((tid + 512) / 12) * 104 + ((tid + 512) % 12) * 8) = rk2;                      \
    u16* vb_ = sVb + (buf) * 64 * 68;                                                              \
    st8(vb_ + (tid >> 3) * 68 + (tid & 7) * 8, rv0);                                               \
    st8(vb_ + ((tid + 256) >> 3) * 68 + (tid & 7) * 8, rv1);                                       \
  } while (0)
  __syncthreads();
  ATT_GLOAD(0);
  ATT_LSTORE(0);
  __syncthreads();
  for (int kt = 0; kt < 36; ++kt) {
    const int buf = kt & 1;
    if (kt + 1 < 36) ATT_GLOAD(kt + 1);
    const u16* sK = sKb + buf * 64 * 104;
    const u16* sV = sVb + buf * 64 * 68;
    f32x16 st[2];
#pragma unroll
    for (int kb = 0; kb < 2; ++kb) {
#pragma unroll
      for (int i = 0; i < 16; ++i) st[kb][i] = 0.f;
#pragma unroll
      for (int ks = 0; ks < 6; ++ks) {
        const bf16x8 a = *(const bf16x8*)(sK + (kb * 32 + r) * 104 + ks * 16 + h * 8);
        st[kb] = MFMA32(a, qf[ks], st[kb]);
      }
    }
    float mx = st[0][0];
#pragma unroll
    for (int kb = 0; kb < 2; ++kb)
#pragma unroll
      for (int i = 0; i < 16; ++i) mx = fmaxf(mx, st[kb][i]);
    mx = fmaxf(mx, shx(mx, 32, lane));
    const float mn = fmaxf(m, mx);
    const float alpha = __builtin_amdgcn_exp2f(m - mn);
    float rsum = 0.f;
#pragma unroll
    for (int kb = 0; kb < 2; ++kb)
#pragma unroll
      for (int i = 0; i < 16; ++i) {
        const float pe = __builtin_amdgcn_exp2f(st[kb][i] - mn);
        st[kb][i] = pe;
        rsum += pe;
      }
    rsum += shx(rsum, 32, lane);
    l = l * alpha + rsum;
    m = mn;
#pragma unroll
    for (int d = 0; d < 2; ++d)
#pragma unroll
      for (int i = 0; i < 16; ++i) o[d][i] *= alpha;
#pragma unroll
    for (int kb = 0; kb < 2; ++kb)
#pragma unroll
      for (int s = 0; s < 2; ++s) {
        const bf16x8 bP = pack8(st[kb], s);
        const int ko = kb * 32 + s * 16 + 4 * h;
#pragma unroll
        for (int d = 0; d < 2; ++d) {
          const u16* vp = sV + (d * 32 + r) * 68 + ko;
          o[d] = MFMA32(cat8(*(const uint2*)vp, *(const uint2*)(vp + 8)), bP, o[d]);
        }
      }
    if (kt + 1 < 36) ATT_LSTORE(buf ^ 1);
    __syncthreads();
  }
  const float inv = 1.f / l;
  u16* Od = (u16*)(p.ws + O_OMLA) + ((size_t)bl * kT + qb * 128 + wid * 32 + r) * 512 + hh * 64;
#pragma unroll
  for (int d = 0; d < 2; ++d)
#pragma unroll
    for (int g = 0; g < 4; ++g) {
      uint2 ov = {pack2(o[d][4 * g] * inv, o[d][4 * g + 1] * inv), pack2(o[d][4 * g + 2] * inv, o[d][4 * g + 3] * inv)};
      *(uint2*)(Od + d * 32 + 8 * g + 4 * h) = ov;
    }
}
DI void attn_pair(const Params& p, int head, int qp, char* smem) {
  const int tid = rtid(), lane = tid & 63, wid = tid >> 6, r = lane & 31, h = lane >> 5;
  const int bl = head >> 3, hh = head & 7;
  const u16* Qp = (const u16*)(p.ws + O_Q) + (((size_t)bl * 8 + hh) * kT + qp * 256) * 96;
  const u16* Kp = (const u16*)(p.ws + O_K) + ((size_t)bl * 8 + hh) * kS * 96;
  const u16* Vp = (const u16*)(p.ws + O_VT) + ((size_t)bl * 8 + hh) * 64 * kS;
  u16* sKb = (u16*)smem;
  u16* sVb = sKb + 2 * 128 * 104;
  bf16x8 qf[6];
#pragma unroll
  for (int ks = 0; ks < 6; ++ks) qf[ks] = *(const bf16x8*)(Qp + (size_t)(wid * 32 + r) * 96 + ks * 16 + h * 8);
  f32x16 o[2];
#pragma unroll
  for (int d = 0; d < 2; ++d)
#pragma unroll
    for (int i = 0; i < 16; ++i) o[d][i] = 0.f;
  float m = -INFINITY, l = 0.f;
  uint4 rk0, rk1, rk2, rv0, rv1;
#define AP_GLOAD(kt)                                                                               \
  do {                                                                                             \
    const u16* kp_ = Kp + (size_t)(kt) * 128 * 96 + (size_t)tid * 8;                               \
    rk0 = *(const uint4*)(kp_);                                                                    \
    rk1 = *(const uint4*)(kp_ + 4096);                                                             \
    rk2 = *(const uint4*)(kp_ + 8192);                                                             \
    rv0 = *(const uint4*)(Vp + (size_t)(tid >> 4) * kS + (kt) * 128 + (tid & 15) * 8);             \
    rv1 = *(const uint4*)(Vp + (size_t)((tid + 512) >> 4) * kS + (kt) * 128 + (tid & 15) * 8);     \
  } while (0)
#define AP_LSTORE(buf)                                                                             \
  do {                                                                                             \
    u16* kb_ = sKb + (buf) * 128 * 104;                                                            \
    *(uint4*)(kb_ + (tid / 12) * 104 + (tid % 12) * 8) = rk0;                                      \
    *(uint4*)(kb_ + ((tid + 512) / 12) * 104 + ((tid + 512) % 12) * 8) = rk1;                      \
    *(uint4*)(kb_ + ((tid + 1024) / 12) * 104 + ((tid + 1024) % 12) * 8) = rk2;                    \
    u16* vb_ = sVb + (buf) * 64 * 132;                                                             \
    st8(vb_ + (tid >> 4) * 132 + (tid & 15) * 8, rv0);                                             \
    st8(vb_ + ((tid + 512) >> 4) * 132 + (tid & 15) * 8, rv1);                                     \
  } while (0)
  __syncthreads();
  AP_GLOAD(0);
  AP_LSTORE(0);
  AP_GLOAD(1);
  __syncthreads();
  for (int kt = 0; kt < 18; ++kt) {
    const int buf = kt & 1;
    if (kt + 1 < 18) AP_LSTORE(buf ^ 1);
    if (kt + 2 < 18) AP_GLOAD(kt + 2);
    const u16* sK = sKb + buf * 128 * 104;
    const u16* sV = sVb + buf * 64 * 132;
    f32x16 st[4];
#pragma unroll
    for (int kb = 0; kb < 4; ++kb) {
#pragma unroll
      for (int i = 0; i < 16; ++i) st[kb][i] = 0.f;
#pragma unroll
      for (int ks = 0; ks < 6; ++ks) {
        const bf16x8 a = *(const bf16x8*)(sK + (kb * 32 + r) * 104 + ks * 16 + h * 8);
        st[kb] = MFMA32(a, qf[ks], st[kb]);
      }
    }
    float mx = st[0][0];
#pragma unroll
    for (int kb = 0; kb < 4; ++kb)
#pragma unroll
      for (int i = 0; i < 16; ++i) mx = fmaxf(mx, st[kb][i]);
    mx = fmaxf(mx, shx(mx, 32, lane));
    const float mn = fmaxf(m, mx);
    const float alpha = __builtin_amdgcn_exp2f(m - mn);
    float rsum = 0.f;
#pragma unroll
    for (int kb = 0; kb < 4; ++kb)
#pragma unroll
      for (int i = 0; i < 16; ++i) {
        const float pe = __builtin_amdgcn_exp2f(st[kb][i] - mn);
        st[kb][i] = pe;
        rsum += pe;
      }
    rsum += shx(rsum, 32, lane);
    l = l * alpha + rsum;
    m = mn;
#pragma unroll
    for (int d = 0; d < 2; ++d)
#pragma unroll
      for (int i = 0; i < 16; ++i) o[d][i] *= alpha;
#pragma unroll
    for (int kb = 0; kb < 4; ++kb)
#pragma unroll
      for (int s = 0; s < 2; ++s) {
        const bf16x8 bP = pack8(st[kb], s);
        const int ko = kb * 32 + s * 16 + 4 * h;
#pragma unroll
        for (int d = 0; d < 2; ++d) {
          const u16* vp = sV + (d * 32 + r) * 132 + ko;
          o[d] = MFMA32(cat8(*(const uint2*)vp, *(const uint2*)(vp + 8)), bP, o[d]);
        }
      }
    __syncthreads();
  }
#undef AP_GLOAD
#undef AP_LSTORE
  const float inv = 1.f / l;
  u16* Od = (u16*)(p.ws + O_OMLA) + ((size_t)bl * kT + qp * 256 + wid * 32 + r) * 512 + hh * 64;
#pragma unroll
  for (int d = 0; d < 2; ++d)
#pragma unroll
    for (int g = 0; g < 4; ++g) {
      uint2 ov = {pack2(o[d][4 * g] * inv, o[d][4 * g + 1] * inv), pack2(o[d][4 * g + 2] * inv, o[d][4 * g + 3] * inv)};
      *(uint2*)(Od + d * 32 + 8 * g + 4 * h) = ov;
    }
}
DI void phase3b(const Params& p, char* smem, char* smemh) {
  const int per_x = gridDim.x >> 3, xcd = blockIdx.x & 7, rank = blockIdx.x >> 3;
  if (per_x == 32) {
    if (rank >= 28) { dn_scan(p, (xcd * 4 + (rank - 28)) * 2 + hid(), smemh); return; }
    for (int w = blockIdx.x; w < 192 + 288; w += 224) {
      if (w < 192) qproj_tile(p, w / 3, w % 3, smem);
      else kvproj_tile(p, (w - 192) >> 2, (w - 192) & 3, smem);
    }
  } else {
    for (int w2 = blockIdx.x; w2 < 32; w2 += gridDim.x) dn_scan(p, 2 * w2 + hid(), smemh);
    FOR_TILES(64, 3, rt, ct) { qproj_tile(p, rt, ct, smem); }
    FOR_TILES(72, 4, rt, ct) { kvproj_tile(p, rt, ct, smem); }
  }
}
DI void phase5(const Params& p, char* smem);
DI void phase4(const Params& p, char* smemh) {
  const int per_x = gridDim.x >> 3, xcd = blockIdx.x & 7, rank = blockIdx.x >> 3;
  if (per_x == 32) {
    char* smem0 = smemh - hid() * 73728;
    for (int it = 0; it < 2; ++it) attn_pair(p, it * 32 + xcd * 4 + (rank >> 3), rank & 7, smem0);
    phase5(p, smemh);
  } else {
    for (int w2 = blockIdx.x; w2 < 512; w2 += gridDim.x) attn_item(p, 2 * w2 + hid(), smemh);
    phase5(p, smemh);
  }
}

DI void phase5(const Params& p, char* smem) {
  const int tid = otid(), lane = tid & 63, wid = tid >> 6, r = lane & 31, h = lane >> 5;
  const int dvb = wid * 32;
  float* red = (float*)smem;
  const u16* Z = (const u16*)(p.ws + O_Z);
  u16* ODN = (u16*)(p.ws + O_ODN);
  for (int w2 = blockIdx.x; w2 < kNB * 32 * 2; w2 += gridDim.x) {
    const int w = 2 * w2 + hid();
    const int hd = w & 3, c = (w >> 2) & 31, bl = w >> 7;
    f32x16 o[2][2];
#pragma unroll
    for (int dir = 0; dir < 2; ++dir) {
      const int item = (((bl * 36 + c) * 4 + hd) << 1) | dir;
      const int sidx = (((bl * 32 + c) * 4 + hd) << 1) | dir;
      const char* ib = p.ws + O_DN + (size_t)item * kDNITEM;
      const u16* VnT = (const u16*)ib;
      const u16* Qg = (const u16*)(ib + 49152);
      const u16* QKd = (const u16*)(ib + 65536);
      const u16* ST = (const u16*)((const char*)p.out + 67108864) + (size_t)sidx * 16384;
#pragma unroll
      for (int mb = 0; mb < 2; ++mb)
#pragma unroll
        for (int i = 0; i < 16; ++i) o[dir][mb][i] = 0.f;
      const u16* STf = ST + wid * 4096 + lane * 8;
      const u16* Vf = VnT + wid * 2048 + lane * 8;
#pragma unroll
      for (int kb = 0; kb < 4; ++kb)
#pragma unroll
        for (int s = 0; s < 2; ++s) {
          const bf16x8 bS = *(const bf16x8*)(STf + (kb * 2 + s) * 512);
          const int ko = kb * 32 + s * 16 + 4 * h;
#pragma unroll
          for (int mb = 0; mb < 2; ++mb) {
            const u16* qp = Qg + (mb * 32 + r) * 128 + ko;
            o[dir][mb] = MFMA32(cat8(*(const uint2*)qp, *(const uint2*)(qp + 8)), bS, o[dir][mb]);
          }
        }
#pragma unroll
      for (int kb2 = 0; kb2 < 2; ++kb2)
#pragma unroll
        for (int s = 0; s < 2; ++s) {
          const bf16x8 bV = *(const bf16x8*)(Vf + (kb2 * 2 + s) * 512);
          const int ko = kb2 * 32 + s * 16 + 4 * h;
#pragma unroll
          for (int mb = 0; mb < 2; ++mb) {
            const u16* qp = QKd + (mb * 32 + r) * 64 + ko;
            o[dir][mb] = MFMA32(cat8(*(const uint2*)qp, *(const uint2*)(qp + 8)), bV, o[dir][mb]);
          }
        }
    }
    float os[2][16];
#pragma unroll
    for (int mb = 0; mb < 2; ++mb)
#pragma unroll
      for (int i = 0; i < 16; ++i) {
        const int ip = (3 - (i & 3)) + 4 * (3 - (i >> 2));
        os[mb][i] = o[0][mb][i] + shx(o[1][1 - mb][ip], 32, lane);
      }
    __syncthreads();
#pragma unroll
    for (int mb = 0; mb < 2; ++mb)
#pragma unroll
      for (int i = 0; i < 16; ++i) {
        float s = os[mb][i] * os[mb][i];
        s += shx(s, 1, lane);
        s += shx(s, 2, lane);
        s += shx(s, 4, lane);
        s += shx(s, 8, lane);
        s += shx(s, 16, lane);
        if (r == 0) red[wid * 64 + mb * 32 + crow(i, h)] = s;
      }
    __syncthreads();
#pragma unroll
    for (int mb = 0; mb < 2; ++mb)
#pragma unroll
      for (int i = 0; i < 16; ++i) {
        const int tok = mb * 32 + crow(i, h);
        const float ss = red[tok] + red[64 + tok] + red[128 + tok] + red[192 + tok];
        const float rstd = rsqrtf(ss * (1.f / 128.f) + kEPS);
        const size_t off = ((size_t)bl * kT + c * 64 + tok) * 512 + hd * 128 + dvb + r;
        ODN[off] = f2bf(os[mb][i] * rstd * siluf_(bf2f(Z[off])));
      }
  }
}

DI void phase6(const Params& p, int pass, char* smem) {
  const u16* GA = (const u16*)(p.ws + O_GA);
  const u16* GB = (const u16*)(p.ws + O_GB);
  u16* M = (u16*)p.out + (size_t)pass * kRL * 1024;
  FOR_TILES(64, 4, rt, ct) {
    f32x4 acc[8][4];
    zero_acc(acc);
    float ss[8];
    gemm256<false>(acc, (const u16*)(p.ws + O_OMLA) + (size_t)rt * 256 * 512, (const u16*)(p.ws + O_WOMLA) + (size_t)ct * 256 * 512,
                   512, smem, ss);
    const int tid = rtid(), wid = tid >> 6, lane = tid & 63, wr = wid >> 2, wc = wid & 3, fr = lane & 15, fq = lane >> 4;
    const int row0 = rt * 256 + wr * 128 + fr, col0 = ct * 256 + wc * 64 + fq * 4;
    FOR_FRAG(m, n) {
      MEMFENCE();
      const size_t off = (size_t)(row0 + m * 16) * 1024 + col0 + n * 16;
      const uint2 ga = *(const uint2*)(GA + off);
      const uint2 o = {pack2(acc[m][n][0] * sigmoidf_(bflo(ga.x)), acc[m][n][1] * sigmoidf_(bfhi(ga.x))),
                       pack2(acc[m][n][2] * sigmoidf_(bflo(ga.y)), acc[m][n][3] * sigmoidf_(bfhi(ga.y)))};
      *(uint2*)(M + off) = o;
    }
  }
  FOR_TILES(64, 4, rt, ct) {
    f32x4 acc[8][4];
    zero_acc(acc);
    float ss[8];
    gemm256<false>(acc, (const u16*)(p.ws + O_ODN) + (size_t)rt * 256 * 512, (const u16*)(p.ws + O_WODN) + (size_t)ct * 256 * 512,
                   512, smem, ss);
    const int tid = rtid(), wid = tid >> 6, lane = tid & 63, wr = wid >> 2, wc = wid & 3, fr = lane & 15, fq = lane >> 4;
    const int row0 = rt * 256 + wr * 128 + fr, col0 = ct * 256 + wc * 64 + fq * 4;
    FOR_FRAG(m, n) {
      MEMFENCE();
      const size_t off = (size_t)(row0 + m * 16) * 1024 + col0 + n * 16;
      const uint2 gb = *(const uint2*)(GB + off);
      const uint2 ya = *(const uint2*)(M + off);
      const uint2 o = {pack2(bflo(ya.x) + acc[m][n][0] * sigmoidf_(bflo(gb.x)), bfhi(ya.x) + acc[m][n][1] * sigmoidf_(bfhi(gb.x))),
                       pack2(bflo(ya.y) + acc[m][n][2] * sigmoidf_(bflo(gb.y)), bfhi(ya.y) + acc[m][n][3] * sigmoidf_(bfhi(gb.y)))};
      *(uint2*)(M + off) = o;
    }
  }
}

template <int K>
DI void gemm_plain(const u16* A, const u16* Bt, u16* C, int ldc, int mt, int nt, char* smem) {
  FOR_TILES(mt, nt, rt, ct) {
    f32x4 acc[8][4];
    zero_acc(acc);
    float ss[8];
    gemm256<false>(acc, A + (size_t)rt * 256 * K, Bt + (size_t)ct * 256 * K, K, smem, ss);
    const int tid = rtid(), wid = tid >> 6, lane = tid & 63, wr = wid >> 2, wc = wid & 3, fr = lane & 15, fq = lane >> 4;

    const int row0 = rt * 256 + wr * 128 + fr, col0 = ct * 256 + wc * 64 + fq * 4;
    FOR_FRAG(m, n) {
      const uint2 o = {pack2(acc[m][n][0], acc[m][n][1]), pack2(acc[m][n][2], acc[m][n][3])};
      *(uint2*)(C + (size_t)(row0 + m * 16) * ldc + col0 + n * 16) = o;
    }
  }
}
DI void phase_ffn_in(const Params& p, char* smem) {
  const u16* A = (const u16*)(p.ws + O_U2);
  const u16* Bt = (const u16*)(p.ws + O_WFFI);
  u16* H = (u16*)(p.ws + O_H);
  const int nranks = gridDim.x >> 3;
  FOR_TILES_N(128, 22, nranks, ((nranks & 1) == 0 ? 2 : 1), rt, ct) {
    f32x4 acc[8][4];
    zero_acc(acc);
    float ss[8];
    gemm256<false>(acc, A + (size_t)rt * 256 * 1024, Bt + (size_t)ct * 256 * 1024, 1024, smem, ss);
    const int tid = rtid(), wid = tid >> 6, lane = tid & 63, wr = wid >> 2, wc = wid & 3, fr = lane & 15, fq = lane >> 4;

    const int row0 = rt * 256 + wr * 128 + fr, hc0 = ct * 128 + wc * 32 + fq * 4;
#pragma unroll
    for (int m = 0; m < 8; ++m)
#pragma unroll
      for (int n2 = 0; n2 < 2; ++n2) {
        const f32x4 g = acc[m][2 * n2], u = acc[m][2 * n2 + 1];
        const uint2 o = {pack2(siluf_(g[0]) * u[0], siluf_(g[1]) * u[1]), pack2(siluf_(g[2]) * u[2], siluf_(g[3]) * u[3])};
        *(uint2*)(H + (size_t)(row0 + m * 16) * kFF + hc0 + n2 * 16) = o;
      }
  }
}

DI void phase_post_mix(const Params& p) {
  const int tid_ = rtid(); const int lane = tid_ & 63, wv = tid_ >> 6;
  const float* mod = (const float*)(p.ws + O_MOD);
  const u16* Y = (const u16*)(p.ws + O_Y);
  u16* U2 = (u16*)(p.ws + O_U2);
  for (int row = blockIdx.x * 8 + wv; row < 32768; row += gridDim.x * 8) {
    const int b = row >> 11;
    const float* md = mod + b * 6144;
    float y[16];
    float ssy = 0.f;
#pragma unroll
    for (int i = 0; i < 4; ++i) {
      const uint2 u = ldnt_u2(Y + (size_t)row * 1024 + i * 256 + lane * 4);
      y[4 * i] = bflo(u.x); y[4 * i + 1] = bfhi(u.x); y[4 * i + 2] = bflo(u.y); y[4 * i + 3] = bfhi(u.y);
#pragma unroll
      for (int e = 0; e < 4; ++e) ssy += y[4 * i + e] * y[4 * i + e];
    }
    ssy = wave_sum(ssy, lane);
    const float rsy = rsqrtf(ssy * (1.f / 1024.f) + kEPS);
    float x1[16];
    float ss1 = 0.f;
#pragma unroll
    for (int i = 0; i < 4; ++i) {
      const int k = i * 256 + lane * 4;
      const float4 xv = ldnt_f4(p.x + (size_t)row * 1024 + k);
      const float4 g = *(const float4*)(p.g_post_mix + k), gt = *(const float4*)(md + 2048 + k);
      x1[4 * i + 0] = xv.x + gt.x * (y[4 * i + 0] * rsy * g.x);
      x1[4 * i + 1] = xv.y + gt.y * (y[4 * i + 1] * rsy * g.y);
      x1[4 * i + 2] = xv.z + gt.z * (y[4 * i + 2] * rsy * g.z);
      x1[4 * i + 3] = xv.w + gt.w * (y[4 * i + 3] * rsy * g.w);
      stnt_f4(p.out + (size_t)row * 1024 + k, make_float4(x1[4 * i], x1[4 * i + 1], x1[4 * i + 2], x1[4 * i + 3]));
#pragma unroll
      for (int e = 0; e < 4; ++e) ss1 += x1[4 * i + e] * x1[4 * i + e];
    }
    ss1 = wave_sum(ss1, lane);
    const float rs1 = rsqrtf(ss1 * (1.f / 1024.f) + kEPS);
#pragma unroll
    for (int i = 0; i < 4; ++i) {
      const int k = i * 256 + lane * 4;
      const float4 g = *(const float4*)(p.g_pre_ffn + k), sh = *(const float4*)(md + 3072 + k), sc = *(const float4*)(md + 4096 + k);
      uint2 o;
      o.x = pack2(x1[4 * i + 0] * rs1 * g.x * (1.f + sc.x) + sh.x, x1[4 * i + 1] * rs1 * g.y * (1.f + sc.y) + sh.y);
      o.y = pack2(x1[4 * i + 2] * rs1 * g.z * (1.f + sc.z) + sh.z, x1[4 * i + 3] * rs1 * g.w * (1.f + sc.w) + sh.w);
      *(uint2*)(U2 + (size_t)row * 1024 + k) = o;
    }
  }
}
DI void phase_final(const Params& p) {
  const int tid_ = rtid(); const int lane = tid_ & 63, wv = tid_ >> 6;
  const float* mod = (const float*)(p.ws + O_MOD);
  const u16* F = (const u16*)(p.ws + O_Y);
  for (int row = blockIdx.x * 8 + wv; row < 32768; row += gridDim.x * 8) {
    const int b = row >> 11;
    const float* md = mod + b * 6144;
    float y[16];
    float ssy = 0.f;
#pragma unroll
    for (int i = 0; i < 4; ++i) {
      const uint2 u = ldnt_u2(F + (size_t)row * 1024 + i * 256 + lane * 4);
      y[4 * i] = bflo(u.x); y[4 * i + 1] = bfhi(u.x); y[4 * i + 2] = bflo(u.y); y[4 * i + 3] = bfhi(u.y);
#pragma unroll
      for (int e = 0; e < 4; ++e) ssy += y[4 * i + e] * y[4 * i + e];
    }
    ssy = wave_sum(ssy, lane);
    const float rsy = rsqrtf(ssy * (1.f / 1024.f) + kEPS);
#pragma unroll
    for (int i = 0; i < 4; ++i) {
      const int k = i * 256 + lane * 4;
      float4 xv = ldnt_f4(p.out + (size_t)row * 1024 + k);
      const float4 g = *(const float4*)(p.g_post_ffn + k), gt = *(const float4*)(md + 5120 + k);
      xv.x += gt.x * (y[4 * i + 0] * rsy * g.x);
      xv.y += gt.y * (y[4 * i + 1] * rsy * g.y);
      xv.z += gt.z * (y[4 * i + 2] * rsy * g.z);
      xv.w += gt.w * (y[4 * i + 3] * rsy * g.w);
      stnt_f4(p.out + (size_t)row * 1024 + k, xv);
    }
  }
}

constexpr int kNPH = 18;
__global__ void __launch_bounds__(512, 2) fwd_kernel(Params pin) {
  __shared__ __attribute__((aligned(1024))) char smem[147456];
  char* smemh = smem + hid() * 73728;
  __shared__ uint4 xb_words;
  if (__builtin_amdgcn_workitem_id_x() == 0) xb_words = make_uint4(0u, 0u, 0u, 0u);
  __syncthreads();
  XcdBarrier xb = xcd_barrier_post((unsigned*)(pin.ws + O_BAR), (volatile LAS unsigned*)&xb_words);
  if (pin.ph_lo > 1000) cg::this_grid().sync();
#define WS_OPAQUE()                                                                          \
  Params p = pin;                                                                            \
  {                                                                                          \
    typedef __attribute__((address_space(1))) char gchar_t;                                  \
    gchar_t* g_ = (gchar_t*)pin.ws;                                                          \
    asm volatile("" : "+s"(g_));                                                             \
    p.ws = (char*)g_;                                                                        \
  }
#define PHASE(k, call)                                                                       \
  if (pin.ph_lo <= (k) && (k) < pin.ph_hi) {                                                 \
    { WS_OPAQUE(); call; }                                                                   \
    if ((k) + 1 < pin.ph_hi) xcd_barrier(xb);                                                \
  }
  PHASE(0, phase0(p, smemh))
  PHASE(1, phase1(p, 0))
  PHASE(2, phase2(p, smem))
  PHASE(3, phase3(p, smemh))
  PHASE(4, phase3b(p, smem, smemh))
  PHASE(5, phase4(p, smemh))
  PHASE(6, phase6(p, 0, smem))
  PHASE(7, phase1(p, 1))
  PHASE(8, phase2(p, smem))
  PHASE(9, phase3(p, smemh))
  PHASE(10, phase3b(p, smem, smemh))
  PHASE(11, phase4(p, smemh))
  PHASE(12, phase6(p, 1, smem))
  PHASE(13, gemm_plain<1024>((const u16*)p.out, (const u16*)(p.ws + O_WOUT), (u16*)(p.ws + O_Y), 1024, 128, 4, smem))
  PHASE(14, phase_post_mix(p))
  PHASE(15, phase_ffn_in(p, smem))
  PHASE(16, gemm_plain<kFF>((const u16*)(p.ws + O_H), (const u16*)(p.ws + O_WFFO), (u16*)(p.ws + O_Y), 1024, 128, 4, smem))
  PHASE(17, phase_final(p))
#undef PHASE
#undef WS_OPAQUE
}

extern "C" void kernel_launch(void* const* d_in, const int* in_sizes, int n_in, void* d_out, int out_size, void* d_ws,
                              size_t ws_size, hipStream_t stream) {
  Params p{};
  const float** f = (const float**)&p;
  for (int i = 0; i < 24; ++i) f[i] = (const float*)d_in[i];
  p.out = (float*)d_out;
  p.ws = (char*)d_ws;
#if COOP
  static int grid_blocks = 0;
  if (!grid_blocks) {
    int dev = 0, cus = 0, per_cu = 0;
    hipGetDevice(&dev);
    hipDeviceGetAttribute(&cus, hipDeviceAttributeMultiprocessorCount, dev);
    hipOccupancyMaxActiveBlocksPerMultiprocessor(&per_cu, fwd_kernel, 512, 0);
    if (per_cu > 1) per_cu = 1;
    grid_blocks = cus * per_cu;
  }
  p.ph_lo = 0;
  p.ph_hi = kNPH;
  hipMemsetAsync((char*)d_ws + O_BAR, 0, 16384, stream);
  void* args[] = {&p};
  hipError_t e = hipLaunchCooperativeKernel((void*)fwd_kernel, dim3(grid_blocks), dim3(512), args, 0, stream);
  if (e != hipSuccess) fprintf(stderr, "cooperative launch failed: %s (grid %d)\n", hipGetErrorString(e), grid_blocks);
#else
  for (int ph = 0; ph < kNPH; ++ph) {
    p.ph_lo = ph;
    p.ph_hi = ph + 1;
    fwd_kernel<<<dim3(256), dim3(512), 0, stream>>>(p);
  }
#endif
}
```
